# Optimizing an MI355X kernel written in HIP

```python
import math
import jax, jax.numpy as jnp
from jax import lax
import numpy as np

D_MODEL = 1024
BATCH = 8
SEQ = 2048
DEPTH = 1

GRID_W = 64
Q_BLOCK = 128
HEAD_DIM = 64
N_DIFF_HEADS = 4
DIFF_V_DIM = 2 * HEAD_DIM
DIFF_WIDTH = N_DIFF_HEADS * DIFF_V_DIM
N_GQA_HEADS = 8
N_GQA_KV = 2
GQA_REP = N_GQA_HEADS // N_GQA_KV
GQA_WIDTH = N_GQA_HEADS * HEAD_DIM
MIX_WIDTH = DIFF_WIDTH + GQA_WIDTH
DQ_COLS = N_DIFF_HEADS * 2 * HEAD_DIM
DK_COLS = N_DIFF_HEADS * 2 * HEAD_DIM
DV_COLS = DIFF_WIDTH
GQ_COLS = N_GQA_HEADS * HEAD_DIM
GK_COLS = N_GQA_KV * HEAD_DIM
GV_COLS = N_GQA_KV * HEAD_DIM
IN_COLS = DQ_COLS + DK_COLS + DV_COLS + GQ_COLS + GK_COLS + GV_COLS
SPLIT_POINTS = [DQ_COLS, DQ_COLS + DK_COLS, DQ_COLS + DK_COLS + DV_COLS,
                DQ_COLS + DK_COLS + DV_COLS + GQ_COLS,
                DQ_COLS + DK_COLS + DV_COLS + GQ_COLS + GK_COLS]
ROPE_THETA = 10000.0
ROPE_AXIS_DIM = HEAD_DIM // 2
N_BUCKETS = 32
MAX_DISTANCE = 128
N_GROUPS = 4
EXPERTS_PER_GROUP = 8
N_EXPERTS = N_GROUPS * EXPERTS_PER_GROUP
TOP_K_INNER = 2
D_EXPERT = D_MODEL // 2
LN_EPS = 1e-5
RMS_EPS = 1e-6
DEEPNORM_ALPHA = (2 * DEPTH) ** 0.25
DEEPNORM_BETA = (8 * DEPTH) ** -0.25

kernel_name = "hybrid_diffattn_axialgqa_hiermoe_encoder"


def layer_norm(x):
    xf = x.astype(jnp.float32)
    mu = jnp.mean(xf, -1, keepdims=True)
    var = jnp.mean(jnp.square(xf - mu), -1, keepdims=True)
    return ((xf - mu) * lax.rsqrt(var + LN_EPS)).astype(x.dtype)


def layer_norm_affine(x, g, b):
    xf = x.astype(jnp.float32)
    mu = jnp.mean(xf, -1, keepdims=True)
    var = jnp.mean(jnp.square(xf - mu), -1, keepdims=True)
    y = (xf - mu) * lax.rsqrt(var + LN_EPS) * g.astype(jnp.float32) + b.astype(jnp.float32)
    return y.astype(x.dtype)


def rms_norm(x, g):
    xf = x.astype(jnp.float32)
    y = xf * lax.rsqrt(jnp.mean(jnp.square(xf), -1, keepdims=True) + RMS_EPS) * g.astype(jnp.float32)
    return y.astype(x.dtype)


def t5_bucket(rel):
    half = N_BUCKETS // 2
    max_exact = half // 2
    ret = jnp.where(rel > 0, half, 0)
    n = jnp.abs(rel)
    nf = jnp.maximum(n, 1).astype(jnp.float32)
    large = max_exact + (jnp.log(nf / max_exact) / math.log(MAX_DISTANCE / max_exact)
                         * (half - max_exact)).astype(jnp.int32)
    large = jnp.minimum(large, half - 1)
    return ret + jnp.where(n < max_exact, n, large)


def axial_rope_tables(seq_len):
    n_rows = seq_len // GRID_W
    rr, cc = jnp.meshgrid(jnp.arange(n_rows), jnp.arange(GRID_W), indexing="ij")
    row = rr.reshape(-1).astype(jnp.float32)
    col = cc.reshape(-1).astype(jnp.float32)
    freqs = ROPE_THETA ** (-jnp.arange(0, ROPE_AXIS_DIM, 2, dtype=jnp.float32) / ROPE_AXIS_DIM)
    ang = jnp.concatenate([row[:, None] * freqs, col[:, None] * freqs], -1)
    return jnp.cos(ang), jnp.sin(ang)


def apply_rope(x, cos, sin):
    xf = x.astype(jnp.float32).reshape(x.shape[:-1] + (HEAD_DIM // 2, 2))
    x1, x2 = xf[..., 0], xf[..., 1]
    c = cos[None, :, None, :]
    s = sin[None, :, None, :]
    out = jnp.stack([x1 * c - x2 * s, x1 * s + x2 * c], -1).reshape(x.shape)
    return out.astype(x.dtype)


def hybrid_mixer(h, w_in, w_out, lam_q1, lam_k1, lam_q2, lam_k2, diff_subln_g,
                 q_norm_g, k_norm_g, rel_bias, lambda_init):
    B, S, _ = h.shape
    n_blocks = S // Q_BLOCK
    proj = h @ w_in
    dq, dk, dv, gq, gk, gv = jnp.split(proj, SPLIT_POINTS, axis=-1)
    dq = dq.reshape(B, S, N_DIFF_HEADS, 2, HEAD_DIM)
    dk = dk.reshape(B, S, N_DIFF_HEADS, 2, HEAD_DIM)
    dv = dv.reshape(B, S, N_DIFF_HEADS, DIFF_V_DIM)
    gq = gq.reshape(B, S, N_GQA_HEADS, HEAD_DIM)
    gk = gk.reshape(B, S, N_GQA_KV, HEAD_DIM)
    gv = gv.reshape(B, S, N_GQA_KV, HEAD_DIM)

    cos, sin = axial_rope_tables(S)
    gq = apply_rope(rms_norm(gq, q_norm_g), cos, sin)
    gk = apply_rope(rms_norm(gk, k_norm_g), cos, sin)

    f32 = jnp.float32
    lam = (jnp.exp(jnp.sum(lam_q1.astype(f32) * lam_k1.astype(f32)))
           - jnp.exp(jnp.sum(lam_q2.astype(f32) * lam_k2.astype(f32))) + lambda_init)

    scale = HEAD_DIM ** -0.5
    dq_b = (dq * scale).reshape(B, n_blocks, Q_BLOCK, N_DIFF_HEADS, 2, HEAD_DIM).transpose(1, 0, 2, 3, 4, 5)
    gq_b = (gq * scale).reshape(B, n_blocks, Q_BLOCK, N_GQA_KV, GQA_REP, HEAD_DIM).transpose(1, 0, 2, 3, 4, 5)
    kpos = jnp.arange(S, dtype=jnp.int32)

    def block(args):
        blk, dqb, gqb = args
        qpos = blk * Q_BLOCK + jnp.arange(Q_BLOCK, dtype=jnp.int32)
        bucket = t5_bucket(kpos[None, :] - qpos[:, None])
        bias = rel_bias[bucket].transpose(2, 0, 1).astype(f32)
        sd = jnp.einsum("bqhcd,bkhcd->bhcqk", dqb, dk).astype(f32) + bias[None, :, None]
        pd = jax.nn.softmax(sd, axis=-1)
        ad = pd[:, :, 0] - lam * pd[:, :, 1]
        od = jnp.einsum("bhqk,bkhe->bqhe", ad.astype(dv.dtype), dv)
        sg = jnp.einsum("bqgrd,bkgd->bgrqk", gqb, gk).astype(f32)
        pg = jax.nn.softmax(sg, axis=-1)
        og = jnp.einsum("bgrqk,bkgd->bqgrd", pg.astype(gv.dtype), gv)
        return od, og

    od, og = lax.map(block, (jnp.arange(n_blocks, dtype=jnp.int32), dq_b, gq_b))
    od = od.transpose(1, 0, 2, 3, 4).reshape(B, S, N_DIFF_HEADS, DIFF_V_DIM)
    od = rms_norm(od, diff_subln_g) * (1.0 - lambda_init)
    og = og.transpose(1, 0, 2, 3, 4, 5).reshape(B, S, GQA_WIDTH)
    mixed = jnp.concatenate([od.reshape(B, S, DIFF_WIDTH), og], axis=-1)
    return mixed @ w_out


def hier_moe(h, w_rg, b_rg, w_re, b_re, w_gate, w_up, w_down):
    B, S, D = h.shape
    t = h.reshape(B * S, D)
    g_logits = (t @ w_rg + b_rg).astype(jnp.float32)
    g_prob = jax.nn.softmax(g_logits, axis=-1)
    g_sel = jnp.argmax(g_logits, axis=-1)
    p_g = jnp.take_along_axis(g_prob, g_sel[:, None], axis=1)[:, 0]
    e_all = (jnp.einsum("td,gde->tge", t, w_re) + b_re).astype(jnp.float32)
    e_logits = jnp.take_along_axis(e_all, g_sel[:, None, None], axis=1)[:, 0]
    top_v, top_i = lax.top_k(e_logits, TOP_K_INNER)
    w2 = jax.nn.softmax(top_v, axis=-1) * p_g[:, None]
    expert_id = g_sel[:, None] * EXPERTS_PER_GROUP + top_i
    combine = jnp.sum(jax.nn.one_hot(expert_id, N_EXPERTS, dtype=jnp.float32) * w2[..., None], axis=1)

    def expert_step(acc, params):
        wg, wu, wd, cw = params
        hid = jax.nn.silu(t @ wg) * (t @ wu)
        return acc + cw[:, None] * (hid @ wd), None

    out, _ = lax.scan(expert_step, jnp.zeros_like(t),
                      (w_gate, w_up, w_down, combine.T.astype(t.dtype)))
    return out.reshape(B, S, D)


def setup_inputs(seed: int = 0) -> dict:
    key = jax.random.key(seed)
    ks = jax.random.split(key, 25)
    L, D = DEPTH, D_MODEL

    def nrm(k, shape, s):
        return jax.random.normal(k, shape, jnp.float32) * s

    col_scale = np.concatenate([
        np.ones(DQ_COLS + DK_COLS), np.full(DV_COLS, DEEPNORM_BETA),
        np.ones(GQ_COLS + GK_COLS), np.full(GV_COLS, DEEPNORM_BETA)]).astype(np.float32)
    return {
        "x": nrm(ks[0], (BATCH, SEQ, D), 1.0),
        "c": nrm(ks[1], (BATCH, D), 1.0),
        "w_ada": nrm(ks[2], (L, D, 6 * D), 0.1 * D ** -0.5),
        "b_ada": nrm(ks[3], (L, 6 * D), 0.01),
        "w_in": nrm(ks[4], (L, D, IN_COLS), D ** -0.5) * jnp.asarray(col_scale),
        "lambda_q1": nrm(ks[5], (L, HEAD_DIM), 0.1),
        "lambda_k1": nrm(ks[6], (L, HEAD_DIM), 0.1),
        "lambda_q2": nrm(ks[7], (L, HEAD_DIM), 0.1),
        "lambda_k2": nrm(ks[8], (L, HEAD_DIM), 0.1),
        "diff_subln_g": 1.0 + nrm(ks[9], (L, DIFF_V_DIM), 0.01),
        "q_norm_g": 1.0 + nrm(ks[10], (L, HEAD_DIM), 0.01),
        "k_norm_g": 1.0 + nrm(ks[11], (L, HEAD_DIM), 0.01),
        "rel_bias": nrm(ks[12], (N_BUCKETS, N_DIFF_HEADS), 0.5),
        "w_out": nrm(ks[13], (L, MIX_WIDTH, D), DEEPNORM_BETA * MIX_WIDTH ** -0.5),
        "ln1_g": 1.0 + nrm(ks[14], (L, D), 0.01),
        "ln1_b": nrm(ks[15], (L, D), 0.01),
        "w_router_group": nrm(ks[16], (L, D, N_GROUPS), D ** -0.5),
        "b_router_group": nrm(ks[17], (L, N_GROUPS), 0.01),
        "w_router_expert": nrm(ks[18], (L, N_GROUPS, D, EXPERTS_PER_GROUP), D ** -0.5),
        "b_router_expert": nrm(ks[19], (L, N_GROUPS, EXPERTS_PER_GROUP), 0.01),
        "w_gate": nrm(ks[20], (L, N_EXPERTS, D, D_EXPERT), D ** -0.5),
        "w_up": nrm(ks[21], (L, N_EXPERTS, D, D_EXPERT), D ** -0.5),
        "w_down": nrm(ks[22], (L, N_EXPERTS, D_EXPERT, D), DEEPNORM_BETA * D_EXPERT ** -0.5),
        "ln2_g": 1.0 + nrm(ks[23], (L, D), 0.01),
        "ln2_b": nrm(ks[24], (L, D), 0.01),
    }


def reference(x, c, w_ada, b_ada, w_in, lambda_q1, lambda_k1, lambda_q2, lambda_k2,
              diff_subln_g, q_norm_g, k_norm_g, rel_bias, w_out, ln1_g, ln1_b,
              w_router_group, b_router_group, w_router_expert, b_router_expert,
              w_gate, w_up, w_down, ln2_g, ln2_b):
    for l in range(DEPTH):
        lambda_init = 0.8 - 0.6 * math.exp(-0.3 * l)
        mod = jax.nn.silu(c) @ w_ada[l] + b_ada[l]
        sh1, sc1, g1, sh2, sc2, g2 = [m[:, None, :] for m in jnp.split(mod, 6, axis=-1)]
        h = layer_norm(x) * (1 + sc1) + sh1
        mix = hybrid_mixer(h, w_in[l], w_out[l], lambda_q1[l], lambda_k1[l], lambda_q2[l],
                           lambda_k2[l], diff_subln_g[l], q_norm_g[l], k_norm_g[l],
                           rel_bias, lambda_init)
        x = layer_norm_affine(DEEPNORM_ALPHA * x + (1 + g1) * mix, ln1_g[l], ln1_b[l])
        h = layer_norm(x) * (1 + sc2) + sh2
        ffn = hier_moe(h, w_router_group[l], b_router_group[l], w_router_expert[l],
                       b_router_expert[l], w_gate[l], w_up[l], w_down[l])
        x = layer_norm_affine(DEEPNORM_ALPHA * x + (1 + g2) * ffn, ln2_g[l], ln2_b[l])
    return x
```

```cpp
#include <hip/hip_runtime.h>
#include <cstdio>
#include <cstdint>

#ifndef MK_N_LAUNCHES
#define MK_N_LAUNCHES 10
#endif

#define GAS __attribute__((address_space(1)))
#define LAS __attribute__((address_space(3)))
typedef unsigned short bf16;
typedef short bf16x8 __attribute__((ext_vector_type(8)));
typedef float f32x4 __attribute__((ext_vector_type(4)));
typedef unsigned u32x4 __attribute__((ext_vector_type(4)));
typedef unsigned u32x2 __attribute__((ext_vector_type(2)));

constexpr int NB = 8, SEQ = 2048, DM = 1024, T = NB * SEQ;
constexpr int INC = 2304;
constexpr int C_DQ = 0, C_DK = 512, C_DV = 1024, C_GQ = 1536, C_GK = 2048, C_GV = 2176;
constexpr int NEXP = 32, DEXP = 512;
constexpr float LN_EPS = 1e-5f, RMS_EPS = 1e-6f;
constexpr float ALPHA = 1.189207115002721f;
constexpr float LAMBDA_INIT = 0.2f;
constexpr float LOG2E = 1.4426950408889634f;
constexpr float C2 = 0.125f * LOG2E;
constexpr int NWAVES = 8, NTHR = 512;
constexpr int NPH = 10;

constexpr size_t MiB = 1u << 20;
constexpr size_t WS_CTL = 0, CTL_ZERO_BYTES = 1 * MiB;
constexpr size_t WS_MOD = 1 * MiB;
constexpr size_t WS_TOKE = 2 * MiB;
constexpr size_t WS_TOKW = 2 * MiB + 256 * 1024;
constexpr size_t WS_TOKP = 2 * MiB + 512 * 1024;
constexpr size_t WS_LIST = 4 * MiB;
constexpr size_t WS_WIN = 8 * MiB;
constexpr size_t WS_WOUT = 14 * MiB;
constexpr size_t WS_WGU = 16 * MiB;
constexpr size_t WS_WD = 80 * MiB;
constexpr size_t WS_H = 112 * MiB;
constexpr size_t WS_PROJ = 144 * MiB;
constexpr size_t WS_MIX = 216 * MiB;
constexpr size_t WS_HID = 216 * MiB;
constexpr size_t WS_YS = 112 * MiB;
constexpr size_t WS_END = 256 * MiB;
constexpr int MAXSLOT = 40960;
constexpr int CW_BAR = 4096;
constexpr int CW_CNT = 16384;

__device__ __forceinline__ unsigned f2bf(float f) { unsigned u = __builtin_bit_cast(unsigned, f); return (u + 0x7fffu + ((u >> 16) & 1u)) >> 16; }
__device__ __forceinline__ unsigned pk2(float lo, float hi) { return f2bf(lo) | (f2bf(hi) << 16); }
__device__ __forceinline__ float bf2f(unsigned short u) { return __builtin_bit_cast(float, (unsigned)u << 16); }
__device__ __forceinline__ float wave_sum(float v) {
#pragma unroll
    for (int o = 1; o < 64; o <<= 1) v += __shfl_xor(v, o);
    return v;
}
__device__ __forceinline__ float half_sum(float v) {
#pragma unroll
    for (int o = 1; o < 32; o <<= 1) v += __shfl_xor(v, o);
    return v;
}

#define XB_TMO      128
#define XB_XCNT(j)  (256  + 64 * (j))
#define XB_XSUB(j)  (1280 + 64 * (j))
#define XB_XGEN(j)  (2304 + 64 * (j))
#define XB_TOP      3328
#define XB_TOPGEN   3392
#define XCD_BAR_WORDS 3456
#define XB_SPIN_CAP (1u << 18)
__device__ __forceinline__ unsigned xb_ld(unsigned* p)              { return __hip_atomic_load(p, __ATOMIC_RELAXED, __HIP_MEMORY_SCOPE_AGENT); }
__device__ __forceinline__ unsigned xb_add(unsigned* p, unsigned v) { return __hip_atomic_fetch_add(p, v, __ATOMIC_RELAXED, __HIP_MEMORY_SCOPE_AGENT); }
__device__ __forceinline__ unsigned xb_xcc_id() { return (unsigned)__builtin_amdgcn_s_getreg((3 << 11) | 20) & 0xFu; }
#define XB_SPIN(cond, bar) do { unsigned _sp = 0; while (cond) { __builtin_amdgcn_s_sleep(1); \
    if ((++_sp & 255u) == 0u) { if (xb_ld(&(bar)[XB_TMO])) break; if (_sp > XB_SPIN_CAP) { atomicAdd(&(bar)[XB_TMO], 1u); break; } } } } while (0)
struct XcdBarrier { unsigned* bar; unsigned x; volatile LAS unsigned* st; };
__device__ __forceinline__ XcdBarrier xcd_barrier_post(unsigned* bar, volatile LAS unsigned* st) {
    XcdBarrier b; b.bar = bar; b.x = xb_xcc_id(); b.st = st;
    if (threadIdx.x == 0) (void)xb_add(&bar[XB_XCNT(b.x)], 1u);
    return b;
}
__device__ __forceinline__ void xcd_barrier_complete(unsigned* bar, unsigned x, unsigned& nloc, unsigned& nx) {
    const unsigned G = gridDim.x * gridDim.y * gridDim.z;
    unsigned sum, cnt, mine, sp = 0u;
    for (;;) {
        sum = 0u; cnt = 0u; mine = 0u;
#pragma unroll
        for (unsigned j = 0; j < 16; ++j) { const unsigned c = xb_ld(&bar[XB_XCNT(j)]); sum += c; cnt += (c > 0u) ? 1u : 0u; mine = (j == x) ? c : mine; }
        if (sum == G) break;
        __builtin_amdgcn_s_sleep(1);
        if ((++sp & 255u) == 0u) { if (xb_ld(&bar[XB_TMO])) break; if (sp > XB_SPIN_CAP) { atomicAdd(&bar[XB_TMO], 1u); break; } }
    }
    nloc = mine > 0u ? mine : 1u; nx = cnt > 0u ? cnt : 1u;
}
__device__ __forceinline__ void xcd_barrier(const XcdBarrier& b) {
    asm volatile("s_waitcnt vmcnt(0)" ::: "memory");
    __syncthreads();
    if (threadIdx.x == 0) {
        unsigned* bar = b.bar;
        __builtin_amdgcn_s_waitcnt(0);
        unsigned nloc = b.st[0], nx = b.st[1];
        if (nloc == 0u) { xcd_barrier_complete(bar, b.x, nloc, nx); b.st[0] = nloc; b.st[1] = nx; }
        const unsigned old = xb_add(&bar[XB_XSUB(b.x)], 1u);
        const unsigned gen = old / nloc;
        if (old + 1u == (gen + 1u) * nloc) {
            __builtin_amdgcn_fence(__ATOMIC_RELEASE, "agent");
            asm volatile("s_waitcnt vmcnt(0)" ::: "memory");
            const unsigned og = xb_add(&bar[XB_TOP], 1u);
            const unsigned tg = og / nx;
            if (og + 1u == (tg + 1u) * nx) xb_add(&bar[XB_TOPGEN], 1u);
            else XB_SPIN(xb_ld(&bar[XB_TOPGEN]) == tg, bar);
            __builtin_amdgcn_fence(__ATOMIC_ACQUIRE, "agent");
            xb_add(&bar[XB_XGEN(b.x)], 1u);
            asm volatile("s_waitcnt vmcnt(0)" ::: "memory");
        } else {
            XB_SPIN(xb_ld(&bar[XB_XGEN(b.x)]) == gen, bar);
            __builtin_amdgcn_fence(__ATOMIC_ACQUIRE, "agent");
            asm volatile("s_waitcnt vmcnt(0)" ::: "memory");
        }
    }
    __syncthreads();
}

struct Args {
    const float* in[25]; float* out; unsigned char* ws; int ph_lo, ph_hi, li, pad;
};
enum { I_X = 0, I_C, I_WADA, I_BADA, I_WIN, I_LQ1, I_LK1, I_LQ2, I_LK2, I_SUBLN, I_QNG, I_KNG, I_RELB, I_WOUT, I_LN1G, I_LN1B,
       I_WRG, I_BRG, I_WRE, I_BRE, I_WGATE, I_WUP, I_WDOWN, I_LN2G, I_LN2B };

constexpr int LDS_BYTES = 147456;
constexpr int MISC_OFF = 131072 + 320;

__device__ __forceinline__ void wave_gemm64(const bf16* (&arow)[4], const bf16* (&brow)[4], int K, f32x4 (&acc)[4][4], int lane) {
    const int kq = (lane >> 4) * 8;
#pragma unroll
    for (int i = 0; i < 4; ++i)
#pragma unroll
        for (int j = 0; j < 4; ++j) acc[i][j] = (f32x4){0.f, 0.f, 0.f, 0.f};
    for (int k0 = 0; k0 < K; k0 += 32) {
        bf16x8 a[4], b[4];
#pragma unroll
        for (int i = 0; i < 4; ++i) a[i] = *(const bf16x8*)(arow[i] + k0 + kq);
#pragma unroll
        for (int j = 0; j < 4; ++j) b[j] = *(const bf16x8*)(brow[j] + k0 + kq);
#pragma unroll
        for (int i = 0; i < 4; ++i)
#pragma unroll
            for (int j = 0; j < 4; ++j) acc[i][j] = __builtin_amdgcn_mfma_f32_16x16x32_bf16(a[i], b[j], acc[i][j], 0, 0, 0);
    }
}

__device__ __forceinline__ void transpose_item(const float* W, int K, int N, bf16* WT, int k0, int n0, int drow0, LAS float* scr, int lane) {
#pragma unroll 8
    for (int i = 0; i < 32; ++i) { const int kk = 2 * i + (lane >> 5); scr[kk * 33 + (lane & 31)] = W[(size_t)(k0 + kk) * N + n0 + (lane & 31)]; }
    asm volatile("s_waitcnt lgkmcnt(0)" ::: "memory");
    const int c = lane & 7;
#pragma unroll
    for (int j = 0; j < 4; ++j) { const int n = (lane >> 3) + 8 * j; const LAS float* s = scr + (8 * c) * 33 + n;
        u32x4 o; o.x = pk2(s[0 * 33], s[1 * 33]); o.y = pk2(s[2 * 33], s[3 * 33]); o.z = pk2(s[4 * 33], s[5 * 33]); o.w = pk2(s[6 * 33], s[7 * 33]);
        *(u32x4*)(WT + (size_t)(drow0 + n) * K + k0 + 8 * c) = o; }
    asm volatile("s_waitcnt lgkmcnt(0)" ::: "memory");
}

__global__ void __launch_bounds__(NTHR, 2) fwd(Args args) {
    extern __shared__ __attribute__((aligned(16))) unsigned char lds_raw[];
    LAS unsigned char* lds = (LAS unsigned char*)lds_raw;
    volatile LAS unsigned* MISC = (volatile LAS unsigned*)(lds + MISC_OFF);
    const int tid = threadIdx.x, lane = tid & 63, wave = __builtin_amdgcn_readfirstlane(tid >> 6);
    const int G = gridDim.x, bid = blockIdx.x;
    unsigned char* ws = args.ws;
    unsigned* ctl = (unsigned*)(ws + WS_CTL);
    for (int u = tid; u < 32; u += NTHR) MISC[u] = 0u;
    __syncthreads();
    XcdBarrier bar; bar.bar = ctl + CW_BAR; bar.x = 0; bar.st = nullptr;
    if (MK_N_LAUNCHES == 1) bar = xcd_barrier_post(ctl + CW_BAR, MISC + 8);
    const int lo = args.ph_lo, hi = args.ph_hi;
#define IN(k) (lo <= (k) && (k) < hi)
#define SEAM(k) do { if (IN(k) && IN((k) + 1)) xcd_barrier(bar); } while (0)

    const float* x = args.in[I_X];
    float* out = args.out;
    float* mod = (float*)(ws + WS_MOD);
    int* tokE = (int*)(ws + WS_TOKE); float* tokW = (float*)(ws + WS_TOKW); int* tokP = (int*)(ws + WS_TOKP);
    int* list = (int*)(ws + WS_LIST);
    bf16* WinT = (bf16*)(ws + WS_WIN); bf16* WoutT = (bf16*)(ws + WS_WOUT); bf16* WguT = (bf16*)(ws + WS_WGU); bf16* WdT = (bf16*)(ws + WS_WD);
    bf16* H = (bf16*)(ws + WS_H); bf16* PROJ = (bf16*)(ws + WS_PROJ); bf16* MIX = (bf16*)(ws + WS_MIX);
    bf16* HID = (bf16*)(ws + WS_HID); bf16* YS = (bf16*)(ws + WS_YS);
    const int gw = bid * NWAVES + wave, NGW = G * NWAVES;

    if (IN(0)) {
        const float* c = args.in[I_C]; const float* w_ada = args.in[I_WADA]; const float* b_ada = args.in[I_BADA];
        if (bid < 96) {
            LAS float* sl = (LAS float*)lds;
            LAS float* part = (LAS float*)(lds + 32768);
            for (int i = tid; i < NB * DM; i += NTHR) { const float v = c[i]; sl[i] = v / (1.f + __expf(-v)); }
            __syncthreads();
            for (int item = bid; item < 96; item += G) {
                const int col = item * 64 + lane;
                float acc[NB];
#pragma unroll
                for (int b = 0; b < NB; ++b) acc[b] = 0.f;
                for (int k = wave * 128; k < wave * 128 + 128; ++k) {
                    const float wv = w_ada[(size_t)k * 6144 + col];
#pragma unroll
                    for (int b = 0; b < NB; ++b) acc[b] += sl[b * DM + k] * wv;
                }
#pragma unroll
                for (int b = 0; b < NB; ++b) part[(wave * NB + b) * 64 + lane] = acc[b];
                __syncthreads();
                { const int b = tid >> 6; float s = 0.f;
#pragma unroll
                  for (int w = 0; w < NWAVES; ++w) s += part[(w * NB + b) * 64 + lane];
                  mod[b * 6144 + col] = s + b_ada[col]; }
                __syncthreads();
            }
        }
        __syncthreads();
        LAS float* scr = (LAS float*)(lds + wave * 16384);
        constexpr int I_IN = 1152, I_OUT = 512, I_EXP = 768, NITEMS = I_IN + I_OUT + NEXP * I_EXP;
        for (int it = gw; it < NITEMS; it += NGW) {
            int r = it;
            if (r < I_IN) { const int kb = r / 72, nb = r % 72; transpose_item(args.in[I_WIN], DM, INC, WinT, 64 * kb, 32 * nb, 32 * nb, scr, lane); continue; } r -= I_IN;
            if (r < I_OUT) { const int kb = r / 32, nb = r % 32; transpose_item(args.in[I_WOUT], DM, DM, WoutT, 64 * kb, 32 * nb, 32 * nb, scr, lane); continue; } r -= I_OUT;
            const int e = r / I_EXP; r -= e * I_EXP;
            if (r < 256) { const int kb = r / 16, nb = r % 16, j0 = 32 * nb;
                transpose_item(args.in[I_WGATE] + (size_t)e * DM * DEXP, DM, DEXP, WguT + (size_t)e * 1024 * 1024, 64 * kb, j0, (j0 >> 7) * 256 + (j0 & 127), scr, lane); continue; } r -= 256;
            if (r < 256) { const int kb = r / 16, nb = r % 16, j0 = 32 * nb;
                transpose_item(args.in[I_WUP] + (size_t)e * DM * DEXP, DM, DEXP, WguT + (size_t)e * 1024 * 1024, 64 * kb, j0, (j0 >> 7) * 256 + 128 + (j0 & 127), scr, lane); continue; } r -= 256;
            { const int kb = r / 32, nb = r % 32;
                transpose_item(args.in[I_WDOWN] + (size_t)e * DEXP * DM, DEXP, DM, WdT + (size_t)e * 1024 * 512, 64 * kb, 32 * nb, 32 * nb, scr, lane); }
        }
    }
    SEAM(0);

    if (IN(1)) {
        for (int m = gw; m < T; m += NGW) {
            const int b = m / SEQ;
            const f32x4* xr = (const f32x4*)(x + (size_t)m * DM) + lane;
            const f32x4* sh = (const f32x4*)(mod + b * 6144) + lane; const f32x4* sc = (const f32x4*)(mod + b * 6144 + 1024) + lane;
            f32x4 v[4]; float s = 0.f;
#pragma unroll
            for (int j = 0; j < 4; ++j) { v[j] = xr[64 * j]; s += (v[j].x + v[j].y) + (v[j].z + v[j].w); }
            const float mean = wave_sum(s) * (1.f / DM); float s2 = 0.f;
#pragma unroll
            for (int j = 0; j < 4; ++j) { v[j] = v[j] - mean; s2 += (v[j].x * v[j].x + v[j].y * v[j].y) + (v[j].z * v[j].z + v[j].w * v[j].w); }
            const float rstd = 1.f / sqrtf(wave_sum(s2) * (1.f / DM) + LN_EPS);
            unsigned long long* o8 = (unsigned long long*)(H + (size_t)m * DM) + lane;
#pragma unroll
            for (int j = 0; j < 4; ++j) { const f32x4 a = sc[64 * j], d = sh[64 * j]; const f32x4 h = v[j] * rstd * (a + 1.f) + d;
                o8[64 * j] = (unsigned long long)pk2(h.x, h.y) | ((unsigned long long)pk2(h.z, h.w) << 32); }
        }
    }
    SEAM(1);

    if (IN(2)) {
        const int wm = wave >> 1, wn = wave & 1;
        for (int u = bid; u < 64 * 9; u += G) {
            const int pm = u / 9, pn = u % 9;
            const int m0 = pm * 256 + wm * 64;
            const bf16* arow[4];
#pragma unroll
            for (int i = 0; i < 4; ++i) arow[i] = H + (size_t)(m0 + 16 * i + (lane & 15)) * DM;
#pragma unroll
            for (int half = 0; half < 2; ++half) {
                const int n0 = pn * 256 + wn * 128 + half * 64;
                const bf16* brow[4];
#pragma unroll
                for (int j = 0; j < 4; ++j) brow[j] = WinT + (size_t)(n0 + 16 * j + (lane & 15)) * DM;
                f32x4 acc[4][4];
                wave_gemm64(arow, brow, DM, acc, lane);
                const float sc = (n0 < C_DK) ? C2 : 1.f;
#pragma unroll
                for (int i = 0; i < 4; ++i)
#pragma unroll
                    for (int j = 0; j < 4; ++j)
#pragma unroll
                        for (int r = 0; r < 4; ++r)
                            PROJ[(size_t)(m0 + 16 * i + 4 * (lane >> 4) + r) * INC + n0 + 16 * j + (lane & 15)] = (bf16)f2bf(acc[i][j][r] * sc);
            }
        }
    }
    SEAM(2);

    if (IN(3)) {
        const float* qg = args.in[I_QNG]; const float* kg = args.in[I_KNG];
        const int hl = lane >> 5, p = lane & 31;
        for (int m = gw; m < T; m += NGW) {
            const int s = m % SEQ; const float pos = (p < 16) ? (float)(s / 64) : (float)(s % 64);
            const float freq = powf(10000.f, -(float)(2 * (p & 15)) / 32.f);
            const float ang = pos * freq; const float cs = cosf(ang), sn = sinf(ang);
#pragma unroll
            for (int it = 0; it < 5; ++it) {
                const int hd = it * 2 + hl;
                const bool isq = hd < 8;
                bf16* ptr = PROJ + (size_t)m * INC + (isq ? C_GQ + hd * 64 : C_GK + (hd - 8) * 64) + 2 * p;
                const unsigned w = *(const unsigned*)ptr;
                const float x1 = bf2f((unsigned short)(w & 0xffffu)), x2 = bf2f((unsigned short)(w >> 16));
                const float ss = half_sum(x1 * x1 + x2 * x2);
                const float r = 1.f / sqrtf(ss * (1.f / 64.f) + RMS_EPS);
                const float* g = isq ? qg : kg;
                const float y1 = x1 * r * g[2 * p], y2 = x2 * r * g[2 * p + 1];
                float o1 = y1 * cs - y2 * sn, o2 = y1 * sn + y2 * cs;
                if (isq) { o1 *= C2; o2 *= C2; }
                *(unsigned*)ptr = pk2(o1, o2);
            }
        }
    }
    SEAM(3);

    if (IN(4)) {
        LAS float* Kt = (LAS float*)lds;
        LAS float* Vt = (LAS float*)(lds + 16384);
        LAS float* tb = (LAS float*)(lds + 49152);
        const float* relb = args.in[I_RELB];
        float lam;
        { float d1 = 0.f, d2 = 0.f;
          for (int i = 0; i < 64; ++i) { d1 += args.in[I_LQ1][i] * args.in[I_LK1][i]; d2 += args.in[I_LQ2][i] * args.in[I_LK2][i]; }
          lam = expf(d1) - expf(d2) + LAMBDA_INIT; }
        float* scratch = out;
        for (int u = bid; u < 384; u += G) {
            const bool diff = u < 128;
            int b, h, qb;
            if (diff) { b = u / 16; h = (u / 4) % 4; qb = u % 4; } else { const int g2 = u - 128; b = g2 / 32; h = (g2 / 4) % 8; qb = g2 % 4; }
            const int qpos = qb * 512 + tid; const size_t trow = (size_t)b * SEQ + qpos;
            if (diff) {
                __syncthreads();
                for (int i = tid; i < 4096; i += NTHR) { const int rel = i - 2048; const int n = rel < 0 ? -rel : rel;
                    int bk; if (n < 8) bk = n; else { const int l2 = 31 - __clz(n * n); bk = 8 + l2 - 6; if (bk > 15) bk = 15; }
                    if (rel > 0) bk += 16;
                    tb[i] = relb[bk * 4 + h] * LOG2E; }
            }
            const int npass = diff ? 4 : 1;
#pragma unroll 1
            for (int ps = 0; ps < npass; ++ps) {
                const int cm = ps >> 1, vh = ps & 1;
                const int qcol = diff ? (C_DQ + h * 128 + cm * 64) : (C_GQ + h * 64);
                const int kcol = diff ? (C_DK + h * 128 + cm * 64) : (C_GK + (h >> 2) * 64);
                const int vcol = diff ? (C_DV + h * 128 + vh * 64) : (C_GV + (h >> 2) * 64);
                float q[64];
#pragma unroll
                for (int d8 = 0; d8 < 8; ++d8) { const bf16x8 qv = *(const bf16x8*)(PROJ + trow * INC + qcol + d8 * 8);
#pragma unroll
                    for (int j = 0; j < 8; ++j) q[d8 * 8 + j] = bf2f((unsigned short)qv[j]); }
                float o[64];
#pragma unroll
                for (int e = 0; e < 64; ++e) o[e] = 0.f;
                float mx = -1e30f, l = 0.f;
#pragma unroll 1
                for (int kt = 0; kt < SEQ / 64; ++kt) {
                    __syncthreads();
                    { const int key = tid >> 3, d0 = (tid & 7) * 8; const size_t krow = (size_t)b * SEQ + kt * 64 + key;
                      const bf16x8 kv = *(const bf16x8*)(PROJ + krow * INC + kcol + d0);
                      const bf16x8 vv = *(const bf16x8*)(PROJ + krow * INC + vcol + d0);
#pragma unroll
                      for (int j = 0; j < 8; ++j) { Kt[key * 64 + d0 + j] = bf2f((unsigned short)kv[j]); Vt[key * 64 + d0 + j] = bf2f((unsigned short)vv[j]); } }
                    __syncthreads();
#pragma unroll 1
                    for (int j = 0; j < 64; ++j) {
                        float s = 0.f;
#pragma unroll
                        for (int d = 0; d < 64; ++d) s += q[d] * Kt[j * 64 + d];
                        if (diff) s += tb[kt * 64 + j - qpos + 2048];
                        if (s > mx) { const float f = exp2f(mx - s); l *= f;
#pragma unroll
                            for (int e = 0; e < 64; ++e) o[e] *= f;
                            mx = s; }
                        const float pp = exp2f(s - mx); l += pp;
#pragma unroll
                        for (int e = 0; e < 64; ++e) o[e] += pp * Vt[j * 64 + e];
                    }
                }
                const float il = 1.f / l;
                if (!diff) {
#pragma unroll
                    for (int e = 0; e < 64; e += 2) *(unsigned*)(MIX + trow * DM + 512 + h * 64 + e) = pk2(o[e] * il, o[e + 1] * il);
                } else if (cm == 0) {
#pragma unroll
                    for (int e = 0; e < 64; ++e) scratch[((size_t)bid * 128 + vh * 64 + e) * NTHR + tid] = o[e] * il;
                } else {
#pragma unroll
                    for (int e = 0; e < 64; ++e) { float* sp = scratch + ((size_t)bid * 128 + vh * 64 + e) * NTHR + tid; *sp = *sp - lam * (o[e] * il); }
                }
            }
            if (diff) {
                float ss = 0.f;
                for (int e = 0; e < 128; ++e) { const float d = scratch[((size_t)bid * 128 + e) * NTHR + tid]; ss += d * d; }
                const float r = (1.f - LAMBDA_INIT) / sqrtf(ss * (1.f / 128.f) + RMS_EPS);
                const float* sg = args.in[I_SUBLN];
                for (int e = 0; e < 128; e += 2) { const float d0 = scratch[((size_t)bid * 128 + e) * NTHR + tid], d1 = scratch[((size_t)bid * 128 + e + 1) * NTHR + tid];
                    *(unsigned*)(MIX + trow * DM + h * 128 + e) = pk2(d0 * r * sg[e], d1 * r * sg[e + 1]); }
            }
        }
    }
    SEAM(4);

    if (IN(5)) {
        const int wm = wave >> 1, wn = wave & 1;
        for (int u = bid; u < 64 * 4; u += G) {
            const int pm = u / 4, pn = u % 4;
            const int m0 = pm * 256 + wm * 64; const int b = m0 / SEQ;
            const bf16* arow[4];
#pragma unroll
            for (int i = 0; i < 4; ++i) arow[i] = MIX + (size_t)(m0 + 16 * i + (lane & 15)) * DM;
#pragma unroll
            for (int half = 0; half < 2; ++half) {
                const int n0 = pn * 256 + wn * 128 + half * 64;
                const bf16* brow[4];
#pragma unroll
                for (int j = 0; j < 4; ++j) brow[j] = WoutT + (size_t)(n0 + 16 * j + (lane & 15)) * DM;
                f32x4 acc[4][4];
                wave_gemm64(arow, brow, DM, acc, lane);
#pragma unroll
                for (int j = 0; j < 4; ++j) { const int col = n0 + 16 * j + (lane & 15); const float g1 = 1.f + mod[b * 6144 + 2048 + col];
#pragma unroll
                    for (int i = 0; i < 4; ++i)
#pragma unroll
                        for (int r = 0; r < 4; ++r) { const size_t idx = (size_t)(m0 + 16 * i + 4 * (lane >> 4) + r) * DM + col;
                            out[idx] = ALPHA * x[idx] + g1 * acc[i][j][r]; } }
            }
        }
    }
    SEAM(5);

    if (IN(6)) {
        const float* g1v = args.in[I_LN1G]; const float* b1v = args.in[I_LN1B];
        const float* wrg = args.in[I_WRG]; const float* brg = args.in[I_BRG]; const float* wre = args.in[I_WRE]; const float* bre = args.in[I_BRE];
        for (int m = gw; m < T; m += NGW) {
            const int b = m / SEQ;
            f32x4* yr = (f32x4*)(out + (size_t)m * DM) + lane;
            f32x4 v[4]; float s = 0.f;
#pragma unroll
            for (int j = 0; j < 4; ++j) { v[j] = yr[64 * j]; s += (v[j].x + v[j].y) + (v[j].z + v[j].w); }
            float mean = wave_sum(s) * (1.f / DM); float s2 = 0.f;
#pragma unroll
            for (int j = 0; j < 4; ++j) { v[j] = v[j] - mean; s2 += (v[j].x * v[j].x + v[j].y * v[j].y) + (v[j].z * v[j].z + v[j].w * v[j].w); }
            float rstd = 1.f / sqrtf(wave_sum(s2) * (1.f / DM) + LN_EPS);
            s = 0.f;
#pragma unroll
            for (int j = 0; j < 4; ++j) { const f32x4 gg = ((const f32x4*)g1v)[64 * j + lane], bb = ((const f32x4*)b1v)[64 * j + lane];
                v[j] = v[j] * rstd * gg + bb; yr[64 * j] = v[j]; s += (v[j].x + v[j].y) + (v[j].z + v[j].w); }
            mean = wave_sum(s) * (1.f / DM); s2 = 0.f;
#pragma unroll
            for (int j = 0; j < 4; ++j) { v[j] = v[j] - mean; s2 += (v[j].x * v[j].x + v[j].y * v[j].y) + (v[j].z * v[j].z + v[j].w * v[j].w); }
            rstd = 1.f / sqrtf(wave_sum(s2) * (1.f / DM) + LN_EPS);
            const f32x4* sh = (const f32x4*)(mod + b * 6144 + 3072) + lane; const f32x4* sc = (const f32x4*)(mod + b * 6144 + 4096) + lane;
            unsigned long long* o8 = (unsigned long long*)(H + (size_t)m * DM) + lane;
#pragma unroll
            for (int j = 0; j < 4; ++j) { v[j] = v[j] * rstd * (sc[64 * j] + 1.f) + sh[64 * j];
                o8[64 * j] = (unsigned long long)pk2(v[j].x, v[j].y) | ((unsigned long long)pk2(v[j].z, v[j].w) << 32); }
            float lg[36];
#pragma unroll
            for (int o = 0; o < 36; ++o) lg[o] = 0.f;
#pragma unroll
            for (int j = 0; j < 4; ++j)
#pragma unroll
                for (int cc = 0; cc < 4; ++cc) { const int col = 4 * lane + 256 * j + cc; const float hv = v[j][cc];
                    const f32x4 wg = *(const f32x4*)(wrg + col * 4);
#pragma unroll
                    for (int o = 0; o < 4; ++o) lg[o] += hv * wg[o];
#pragma unroll
                    for (int g = 0; g < 4; ++g) { const f32x4 w0 = *(const f32x4*)(wre + ((size_t)g * DM + col) * 8), w1 = *(const f32x4*)(wre + ((size_t)g * DM + col) * 8 + 4);
#pragma unroll
                        for (int o = 0; o < 4; ++o) { lg[4 + g * 8 + o] += hv * w0[o]; lg[4 + g * 8 + 4 + o] += hv * w1[o]; } } }
#pragma unroll
            for (int o = 0; o < 36; ++o) lg[o] = wave_sum(lg[o]);
            if (lane == 0) {
                volatile LAS float* wl = (volatile LAS float*)(lds + 131072 + 8192 + wave * 256);
                float gl[4]; int gs = 0;
#pragma unroll
                for (int o = 0; o < 4; ++o) gl[o] = lg[o] + brg[o];
                float gmax = gl[0];
#pragma unroll
                for (int o = 1; o < 4; ++o) if (gl[o] > gmax) { gmax = gl[o]; gs = o; }
                float den = 0.f;
#pragma unroll
                for (int o = 0; o < 4; ++o) den += expf(gl[o] - gmax);
                const float pg = 1.f / den;
                float el[8];
#pragma unroll
                for (int o = 0; o < 32; ++o) wl[o] = lg[4 + o];
#pragma unroll
                for (int o = 0; o < 8; ++o) el[o] = wl[gs * 8 + o] + bre[gs * 8 + o];
                int i1 = 0; float v1 = el[0];
#pragma unroll
                for (int o = 1; o < 8; ++o) if (el[o] > v1) { v1 = el[o]; i1 = o; }
                int i2 = -1; float v2 = -3.0e38f;
#pragma unroll
                for (int o = 0; o < 8; ++o) if (o != i1 && (i2 < 0 || el[o] > v2)) { v2 = el[o]; i2 = o; }
                const float ex = expf(v2 - v1);
                const float wa = pg / (1.f + ex), wb = pg * ex / (1.f + ex);
                const int e1 = gs * 8 + i1, e2 = gs * 8 + i2;
                const int p1 = (int)atomicAdd(ctl + CW_CNT + 64 * e1, 1u); const int p2 = (int)atomicAdd(ctl + CW_CNT + 64 * e2, 1u);
                list[(size_t)e1 * T + p1] = m; list[(size_t)e2 * T + p2] = m;
                tokE[2 * m] = e1; tokE[2 * m + 1] = e2; tokW[2 * m] = wa; tokW[2 * m + 1] = wb; tokP[2 * m] = p1; tokP[2 * m + 1] = p2;
            }
        }
    }
    SEAM(6);

    LAS int* toff = (LAS int*)(lds + 131072 + 4096);
    if (hi > 7) {
        __syncthreads();
        if (tid == 0) { int acc = 0; for (int e = 0; e < NEXP; ++e) { const int cnt = (int)__hip_atomic_load(ctl + CW_CNT + 64 * e, __ATOMIC_RELAXED, __HIP_MEMORY_SCOPE_AGENT);
            toff[e] = acc; toff[64 + e] = cnt; acc += (cnt + 255) >> 8; } toff[32] = acc; }
        __syncthreads();
    }

    if (IN(7)) {
        const int wm = wave >> 1, wn = wave & 1;
        const int ntile = toff[32];
        for (int u = bid; u < ntile * 4; u += G) {
            const int tile = u >> 2, pn = u & 3;
            int e = 0;
            for (int k = 1; k < NEXP; ++k) if (toff[k] <= tile) e = k;
            const int cnt = toff[64 + e]; const int r0 = (tile - toff[e]) * 256 + wm * 64;
            const bf16* arow[4];
#pragma unroll
            for (int i = 0; i < 4; ++i) { const int rr = r0 + 16 * i + (lane & 15); const int tok = (rr < cnt) ? list[(size_t)e * T + rr] : 0; arow[i] = H + (size_t)tok * DM; }
            const bf16* Wt = WguT + (size_t)e * 1024 * 1024 + (size_t)pn * 256 * 1024;
            const bf16* brow[4];
            f32x4 accg[4][4], accu[4][4];
#pragma unroll
            for (int j = 0; j < 4; ++j) brow[j] = Wt + (size_t)(wn * 64 + 16 * j + (lane & 15)) * DM;
            wave_gemm64(arow, brow, DM, accg, lane);
#pragma unroll
            for (int j = 0; j < 4; ++j) brow[j] = Wt + (size_t)(128 + wn * 64 + 16 * j + (lane & 15)) * DM;
            wave_gemm64(arow, brow, DM, accu, lane);
            const size_t slot0 = (size_t)tile * 256 + wm * 64;
#pragma unroll
            for (int i = 0; i < 4; ++i)
#pragma unroll
                for (int j = 0; j < 4; ++j)
#pragma unroll
                    for (int r = 0; r < 4; ++r) { const float gt = accg[i][j][r], up = accu[i][j][r];
                        HID[(slot0 + 16 * i + 4 * (lane >> 4) + r) * DEXP + pn * 128 + wn * 64 + 16 * j + (lane & 15)] = (bf16)f2bf(gt / (1.f + __expf(-gt)) * up); }
        }
    }
    SEAM(7);

    if (IN(8)) {
        const int wm = wave >> 1, wn = wave & 1;
        const int ntile = toff[32];
        for (int u = bid; u < ntile * 4; u += G) {
            const int tile = u >> 2, pn = u & 3;
            int e = 0;
            for (int k = 1; k < NEXP; ++k) if (toff[k] <= tile) e = k;
            const size_t slot0 = (size_t)tile * 256 + wm * 64;
            const bf16* arow[4];
#pragma unroll
            for (int i = 0; i < 4; ++i) arow[i] = HID + (slot0 + 16 * i + (lane & 15)) * DEXP;
#pragma unroll
            for (int half = 0; half < 2; ++half) {
                const int n0 = pn * 256 + wn * 128 + half * 64;
                const bf16* brow[4];
#pragma unroll
                for (int j = 0; j < 4; ++j) brow[j] = WdT + (size_t)e * 1024 * 512 + (size_t)(n0 + 16 * j + (lane & 15)) * DEXP;
                f32x4 acc[4][4];
                wave_gemm64(arow, brow, DEXP, acc, lane);
#pragma unroll
                for (int i = 0; i < 4; ++i)
#pragma unroll
                    for (int j = 0; j < 4; ++j)
#pragma unroll
                        for (int r = 0; r < 4; ++r)
                            YS[(slot0 + 16 * i + 4 * (lane >> 4) + r) * DM + n0 + 16 * j + (lane & 15)] = (bf16)f2bf(acc[i][j][r]);
            }
        }
    }
    SEAM(8);

    if (IN(9)) {
        const float* g2v = args.in[I_LN2G]; const float* b2v = args.in[I_LN2B];
        for (int m = gw; m < T; m += NGW) {
            const int b = m / SEQ;
            const int e1 = tokE[2 * m], e2 = tokE[2 * m + 1]; const float wa = tokW[2 * m], wb = tokW[2 * m + 1];
            const size_t sa = (size_t)toff[e1] * 256 + tokP[2 * m], sb = (size_t)toff[e2] * 256 + tokP[2 * m + 1];
            f32x4* xr = (f32x4*)(out + (size_t)m * DM) + lane;
            const u32x2* ya = (const u32x2*)(YS + sa * DM) + lane; const u32x2* yb = (const u32x2*)(YS + sb * DM) + lane;
            const f32x4* gg2 = (const f32x4*)(mod + b * 6144 + 5120) + lane;
            f32x4 v[4]; float s = 0.f;
#pragma unroll
            for (int j = 0; j < 4; ++j) { const f32x4 xv = xr[64 * j]; const u32x2 a = ya[64 * j], bq = yb[64 * j]; const f32x4 g2 = gg2[64 * j] + 1.f;
                f32x4 fa, fb;
                fa.x = bf2f((unsigned short)(a.x & 0xffffu)); fa.y = bf2f((unsigned short)(a.x >> 16)); fa.z = bf2f((unsigned short)(a.y & 0xffffu)); fa.w = bf2f((unsigned short)(a.y >> 16));
                fb.x = bf2f((unsigned short)(bq.x & 0xffffu)); fb.y = bf2f((unsigned short)(bq.x >> 16)); fb.z = bf2f((unsigned short)(bq.y & 0xffffu)); fb.w = bf2f((unsigned short)(bq.y >> 16));
                v[j] = xv * ALPHA + g2 * (fa * wa + fb * wb); s += (v[j].x + v[j].y) + (v[j].z + v[j].w); }
            const float mean = wave_sum(s) * (1.f / DM); float s2 = 0.f;
#pragma unroll
            for (int j = 0; j < 4; ++j) { v[j] = v[j] - mean; s2 += (v[j].x * v[j].x + v[j].y * v[j].y) + (v[j].z * v[j].z + v[j].w * v[j].w); }
            const float rstd = 1.f / sqrtf(wave_sum(s2) * (1.f / DM) + LN_EPS);
#pragma unroll
            for (int j = 0; j < 4; ++j) { const f32x4 gg = ((const f32x4*)g2v)[64 * j + lane], bb = ((const f32x4*)b2v)[64 * j + lane]; xr[64 * j] = v[j] * rstd * gg + bb; }
        }
    }
#undef IN
#undef SEAM
}

extern "C" void kernel_launch(void* const* d_in, const int* in_sizes, int n_in, void* d_out, int out_size, void* d_ws, size_t ws_size, hipStream_t stream) {
    static int grid = 0;
    if (grid == 0) {
        if (n_in != 25 || out_size != T * DM || ws_size < WS_END) { fprintf(stderr, "kernel_launch: unexpected shapes (n_in %d out %d ws %zu)\n", n_in, out_size, ws_size); grid = -1; return; }
        int dev = 0, cus = 0, per_cu = 0;
        if (hipGetDevice(&dev) != hipSuccess || hipDeviceGetAttribute(&cus, hipDeviceAttributeMultiprocessorCount, dev) != hipSuccess) { grid = -1; return; }
        if (hipFuncSetAttribute((const void*)fwd, hipFuncAttributeMaxDynamicSharedMemorySize, LDS_BYTES) != hipSuccess) { fprintf(stderr, "kernel_launch: hipFuncSetAttribute failed\n"); grid = -1; return; }
        if (hipOccupancyMaxActiveBlocksPerMultiprocessor(&per_cu, (const void*)fwd, NTHR, LDS_BYTES) != hipSuccess || per_cu < 1) { fprintf(stderr, "kernel_launch: occupancy query says %d\n", per_cu); }
        (void)hipGetLastError();
        grid = cus;
    }
    if (grid < 0) return;
    (void)hipMemsetAsync((char*)d_ws + WS_CTL, 0, CTL_ZERO_BYTES, stream);
    Args a{};
    for (int i = 0; i < 25; ++i) a.in[i] = (const float*)d_in[i];
    a.out = (float*)d_out; a.ws = (unsigned char*)d_ws; a.pad = 0;
    if (MK_N_LAUNCHES == 1) {
        a.ph_lo = 0; a.ph_hi = NPH; a.li = 0;
        hipLaunchKernelGGL(fwd, dim3(grid), dim3(NTHR), LDS_BYTES, stream, a);
    } else {
        for (int p = 0; p < NPH; ++p) { a.ph_lo = p; a.ph_hi = p + 1; a.li = p; hipLaunchKernelGGL(fwd, dim3(grid), dim3(NTHR), LDS_BYTES, stream, a); }
    }
}
```

```cpp
#include <hip/hip_runtime.h>
#include <cstdio>
#include <cstdint>

#ifndef MK_N_LAUNCHES
#define MK_N_LAUNCHES 1
#endif

#define GAS __attribute__((address_space(1)))
#define LAS __attribute__((address_space(3)))
typedef unsigned short bf16;
typedef short bf16x8 __attribute__((ext_vector_type(8)));
typedef float f32x4 __attribute__((ext_vector_type(4)));
typedef unsigned u32x4 __attribute__((ext_vector_type(4)));
typedef unsigned u32x2 __attribute__((ext_vector_type(2)));

constexpr int NB = 8, SEQ = 2048, DM = 1024, T = NB * SEQ;
constexpr int INC = 2304;
constexpr int C_DQ = 0, C_DK = 512, C_DV = 1024, C_GQ = 1536, C_GK = 2048, C_GV = 2176;
constexpr int NEXP = 32, DEXP = 512;
constexpr float LN_EPS = 1e-5f, RMS_EPS = 1e-6f;
constexpr float ALPHA = 1.189207115002721f;
constexpr float LAMBDA_INIT = 0.2f;
constexpr float LOG2E = 1.4426950408889634f;
constexpr float C2 = 0.125f * LOG2E;
constexpr int NWAVES = 8, NTHR = 512;
constexpr int NPH = 10;

constexpr size_t MiB = 1u << 20;
constexpr size_t WS_CTL = 0, CTL_ZERO_BYTES = 1 * MiB;
constexpr size_t WS_MOD = 1 * MiB;
constexpr size_t WS_TOKE = 2 * MiB;
constexpr size_t WS_TOKW = 2 * MiB + 256 * 1024;
constexpr size_t WS_TOKP = 2 * MiB + 512 * 1024;
constexpr size_t WS_LIST = 4 * MiB;
constexpr size_t WS_WIN = 8 * MiB;
constexpr size_t WS_WOUT = 14 * MiB;
constexpr size_t WS_WGU = 16 * MiB;
constexpr size_t WS_WD = 80 * MiB;
constexpr size_t WS_H = 112 * MiB;
constexpr size_t WS_PROJ = 144 * MiB;
constexpr size_t WS_MIX = 216 * MiB;
constexpr size_t WS_HID = 216 * MiB;
constexpr size_t WS_YS = 112 * MiB;
constexpr size_t WS_END = 256 * MiB;
constexpr int MAXSLOT = 40960;
constexpr int CW_BAR = 4096;
constexpr int CW_CNT = 16384;

__device__ __forceinline__ unsigned f2bf(float f) { unsigned u = __builtin_bit_cast(unsigned, f); return (u + 0x7fffu + ((u >> 16) & 1u)) >> 16; }
__device__ __forceinline__ unsigned pk2(float lo, float hi) { return f2bf(lo) | (f2bf(hi) << 16); }
__device__ __forceinline__ float bf2f(unsigned short u) { return __builtin_bit_cast(float, (unsigned)u << 16); }
__device__ __forceinline__ float wave_sum(float v) {
#pragma unroll
    for (int o = 1; o < 64; o <<= 1) v += __shfl_xor(v, o);
    return v;
}
__device__ __forceinline__ float half_sum(float v) {
#pragma unroll
    for (int o = 1; o < 32; o <<= 1) v += __shfl_xor(v, o);
    return v;
}

#define XB_TMO      128
#define XB_XCNT(j)  (256  + 64 * (j))
#define XB_XSUB(j)  (1280 + 64 * (j))
#define XB_XGEN(j)  (2304 + 64 * (j))
#define XB_TOP      3328
#define XB_TOPGEN   3392
#define XCD_BAR_WORDS 3456
#define XB_SPIN_CAP (1u << 18)
__device__ __forceinline__ unsigned xb_ld(unsigned* p)              { return __hip_atomic_load(p, __ATOMIC_RELAXED, __HIP_MEMORY_SCOPE_AGENT); }
__device__ __forceinline__ unsigned xb_add(unsigned* p, unsigned v) { return __hip_atomic_fetch_add(p, v, __ATOMIC_RELAXED, __HIP_MEMORY_SCOPE_AGENT); }
__device__ __forceinline__ unsigned xb_xcc_id() { return (unsigned)__builtin_amdgcn_s_getreg((3 << 11) | 20) & 0xFu; }
#define XB_SPIN(cond, bar) do { unsigned _sp = 0; while (cond) { __builtin_amdgcn_s_sleep(1); \
    if ((++_sp & 255u) == 0u) { if (xb_ld(&(bar)[XB_TMO])) break; if (_sp > XB_SPIN_CAP) { atomicAdd(&(bar)[XB_TMO], 1u); break; } } } } while (0)
struct XcdBarrier { unsigned* bar; unsigned x; volatile LAS unsigned* st; };
__device__ __forceinline__ XcdBarrier xcd_barrier_post(unsigned* bar, volatile LAS unsigned* st) {
    XcdBarrier b; b.bar = bar; b.x = xb_xcc_id(); b.st = st;
    if (threadIdx.x == 0) (void)xb_add(&bar[XB_XCNT(b.x)], 1u);
    return b;
}
__device__ __forceinline__ void xcd_barrier_complete(unsigned* bar, unsigned x, unsigned& nloc, unsigned& nx) {
    const unsigned G = gridDim.x * gridDim.y * gridDim.z;
    unsigned sum, cnt, mine, sp = 0u;
    for (;;) {
        sum = 0u; cnt = 0u; mine = 0u;
#pragma unroll
        for (unsigned j = 0; j < 16; ++j) { const unsigned c = xb_ld(&bar[XB_XCNT(j)]); sum += c; cnt += (c > 0u) ? 1u : 0u; mine = (j == x) ? c : mine; }
        if (sum == G) break;
        __builtin_amdgcn_s_sleep(1);
        if ((++sp & 255u) == 0u) { if (xb_ld(&bar[XB_TMO])) break; if (sp > XB_SPIN_CAP) { atomicAdd(&bar[XB_TMO], 1u); break; } }
    }
    nloc = mine > 0u ? mine : 1u; nx = cnt > 0u ? cnt : 1u;
}
__device__ __forceinline__ void xcd_barrier(const XcdBarrier& b) {
    asm volatile("s_waitcnt vmcnt(0)" ::: "memory");
    __syncthreads();
    if (threadIdx.x == 0) {
        unsigned* bar = b.bar;
        __builtin_amdgcn_s_waitcnt(0);
        unsigned nloc = b.st[0], nx = b.st[1];
        if (nloc == 0u) { xcd_barrier_complete(bar, b.x, nloc, nx); b.st[0] = nloc; b.st[1] = nx; }
        const unsigned old = xb_add(&bar[XB_XSUB(b.x)], 1u);
        const unsigned gen = old / nloc;
        if (old + 1u == (gen + 1u) * nloc) {
            __builtin_amdgcn_fence(__ATOMIC_RELEASE, "agent");
            asm volatile("s_waitcnt vmcnt(0)" ::: "memory");
            const unsigned og = xb_add(&bar[XB_TOP], 1u);
            const unsigned tg = og / nx;
            if (og + 1u == (tg + 1u) * nx) xb_add(&bar[XB_TOPGEN], 1u);
            else XB_SPIN(xb_ld(&bar[XB_TOPGEN]) == tg, bar);
            __builtin_amdgcn_fence(__ATOMIC_ACQUIRE, "agent");
            xb_add(&bar[XB_XGEN(b.x)], 1u);
            asm volatile("s_waitcnt vmcnt(0)" ::: "memory");
        } else {
            XB_SPIN(xb_ld(&bar[XB_XGEN(b.x)]) == gen, bar);
            __builtin_amdgcn_fence(__ATOMIC_ACQUIRE, "agent");
            asm volatile("s_waitcnt vmcnt(0)" ::: "memory");
        }
    }
    __syncthreads();
}

struct Args {
    const float* in[25]; float* out; unsigned char* ws; int ph_lo, ph_hi, li, pad;
};
enum { I_X = 0, I_C, I_WADA, I_BADA, I_WIN, I_LQ1, I_LK1, I_LQ2, I_LK2, I_SUBLN, I_QNG, I_KNG, I_RELB, I_WOUT, I_LN1G, I_LN1B,
       I_WRG, I_BRG, I_WRE, I_BRE, I_WGATE, I_WUP, I_WDOWN, I_LN2G, I_LN2B };

constexpr int LDS_BYTES = 147456;
constexpr int MISC_OFF = 131072 + 320;

__device__ __forceinline__ void wave_gemm64(const bf16* (&arow)[4], const bf16* (&brow)[4], int K, f32x4 (&acc)[4][4], int lane) {
    const int kq = (lane >> 4) * 8;
#pragma unroll
    for (int i = 0; i < 4; ++i)
#pragma unroll
        for (int j = 0; j < 4; ++j) acc[i][j] = (f32x4){0.f, 0.f, 0.f, 0.f};
    for (int k0 = 0; k0 < K; k0 += 32) {
        bf16x8 a[4], b[4];
#pragma unroll
        for (int i = 0; i < 4; ++i) a[i] = *(const bf16x8*)(arow[i] + k0 + kq);
#pragma unroll
        for (int j = 0; j < 4; ++j) b[j] = *(const bf16x8*)(brow[j] + k0 + kq);
#pragma unroll
        for (int i = 0; i < 4; ++i)
#pragma unroll
            for (int j = 0; j < 4; ++j) acc[i][j] = __builtin_amdgcn_mfma_f32_16x16x32_bf16(a[i], b[j], acc[i][j], 0, 0, 0);
    }
}

__device__ __forceinline__ void transpose_item(const float* W, int K, int N, bf16* WT, int k0, int n0, int drow0, LAS float* scr, int lane) {
#pragma unroll 8
    for (int i = 0; i < 32; ++i) { const int kk = 2 * i + (lane >> 5); scr[kk * 33 + (lane & 31)] = W[(size_t)(k0 + kk) * N + n0 + (lane & 31)]; }
    asm volatile("s_waitcnt lgkmcnt(0)" ::: "memory");
    const int c = lane & 7;
#pragma unroll
    for (int j = 0; j < 4; ++j) { const int n = (lane >> 3) + 8 * j; const LAS float* s = scr + (8 * c) * 33 + n;
        u32x4 o; o.x = pk2(s[0 * 33], s[1 * 33]); o.y = pk2(s[2 * 33], s[3 * 33]); o.z = pk2(s[4 * 33], s[5 * 33]); o.w = pk2(s[6 * 33], s[7 * 33]);
        *(u32x4*)(WT + (size_t)(drow0 + n) * K + k0 + 8 * c) = o; }
    asm volatile("s_waitcnt lgkmcnt(0)" ::: "memory");
}

__global__ void __launch_bounds__(NTHR, 2) fwd(Args args) {
    extern __shared__ __attribute__((aligned(16))) unsigned char lds_raw[];
    LAS unsigned char* lds = (LAS unsigned char*)lds_raw;
    volatile LAS unsigned* MISC = (volatile LAS unsigned*)(lds + MISC_OFF);
    const int tid = threadIdx.x, lane = tid & 63, wave = __builtin_amdgcn_readfirstlane(tid >> 6);
    const int G = gridDim.x, bid = blockIdx.x;
    unsigned char* ws = args.ws;
    unsigned* ctl = (unsigned*)(ws + WS_CTL);
    for (int u = tid; u < 32; u += NTHR) MISC[u] = 0u;
    __syncthreads();
    XcdBarrier bar; bar.bar = ctl + CW_BAR; bar.x = 0; bar.st = nullptr;
    if (MK_N_LAUNCHES == 1) bar = xcd_barrier_post(ctl + CW_BAR, MISC + 8);
    const int lo = args.ph_lo, hi = args.ph_hi;
#define IN(k) (lo <= (k) && (k) < hi)
#define SEAM(k) do { if (IN(k) && IN((k) + 1)) xcd_barrier(bar); } while (0)

    const float* x = args.in[I_X];
    float* out = args.out;
    float* mod = (float*)(ws + WS_MOD);
    int* tokE = (int*)(ws + WS_TOKE); float* tokW = (float*)(ws + WS_TOKW); int* tokP = (int*)(ws + WS_TOKP);
    int* list = (int*)(ws + WS_LIST);
    bf16* WinT = (bf16*)(ws + WS_WIN); bf16* WoutT = (bf16*)(ws + WS_WOUT); bf16* WguT = (bf16*)(ws + WS_WGU); bf16* WdT = (bf16*)(ws + WS_WD);
    bf16* H = (bf16*)(ws + WS_H); bf16* PROJ = (bf16*)(ws + WS_PROJ); bf16* MIX = (bf16*)(ws + WS_MIX);
    bf16* HID = (bf16*)(ws + WS_HID); bf16* YS = (bf16*)(ws + WS_YS);
    const int gw = bid * NWAVES + wave, NGW = G * NWAVES;

    if (IN(0)) {
        const float* c = args.in[I_C]; const float* w_ada = args.in[I_WADA]; const float* b_ada = args.in[I_BADA];
        if (bid < 96) {
            LAS float* sl = (LAS float*)lds;
            LAS float* part = (LAS float*)(lds + 32768);
            for (int i = tid; i < NB * DM; i += NTHR) { const float v = c[i]; sl[i] = v / (1.f + __expf(-v)); }
            __syncthreads();
            for (int item = bid; item < 96; item += G) {
                const int col = item * 64 + lane;
                float acc[NB];
#pragma unroll
                for (int b = 0; b < NB; ++b) acc[b] = 0.f;
                for (int k = wave * 128; k < wave * 128 + 128; ++k) {
                    const float wv = w_ada[(size_t)k * 6144 + col];
#pragma unroll
                    for (int b = 0; b < NB; ++b) acc[b] += sl[b * DM + k] * wv;
                }
#pragma unroll
                for (int b = 0; b < NB; ++b) part[(wave * NB + b) * 64 + lane] = acc[b];
                __syncthreads();
                { const int b = tid >> 6; float s = 0.f;
#pragma unroll
                  for (int w = 0; w < NWAVES; ++w) s += part[(w * NB + b) * 64 + lane];
                  mod[b * 6144 + col] = s + b_ada[col]; }
                __syncthreads();
            }
        }
        __syncthreads();
        LAS float* scr = (LAS float*)(lds + wave * 16384);
        constexpr int I_IN = 1152, I_OUT = 512, I_EXP = 768, NITEMS = I_IN + I_OUT + NEXP * I_EXP;
        for (int it = gw; it < NITEMS; it += NGW) {
            int r = it;
            if (r < I_IN) { const int kb = r / 72, nb = r % 72; transpose_item(args.in[I_WIN], DM, INC, WinT, 64 * kb, 32 * nb, 32 * nb, scr, lane); continue; } r -= I_IN;
            if (r < I_OUT) { const int kb = r / 32, nb = r % 32; transpose_item(args.in[I_WOUT], DM, DM, WoutT, 64 * kb, 32 * nb, 32 * nb, scr, lane); continue; } r -= I_OUT;
            const int e = r / I_EXP; r -= e * I_EXP;
            if (r < 256) { const int kb = r / 16, nb = r % 16, j0 = 32 * nb;
                transpose_item(args.in[I_WGATE] + (size_t)e * DM * DEXP, DM, DEXP, WguT + (size_t)e * 1024 * 1024, 64 * kb, j0, (j0 >> 7) * 256 + (j0 & 127), scr, lane); continue; } r -= 256;
            if (r < 256) { const int kb = r / 16, nb = r % 16, j0 = 32 * nb;
                transpose_item(args.in[I_WUP] + (size_t)e * DM * DEXP, DM, DEXP, WguT + (size_t)e * 1024 * 1024, 64 * kb, j0, (j0 >> 7) * 256 + 128 + (j0 & 127), scr, lane); continue; } r -= 256;
            { const int kb = r / 32, nb = r % 32;
                transpose_item(args.in[I_WDOWN] + (size_t)e * DEXP * DM, DEXP, DM, WdT + (size_t)e * 1024 * 512, 64 * kb, 32 * nb, 32 * nb, scr, lane); }
        }
    }
    SEAM(0);

    if (IN(1)) {
        for (int m = gw; m < T; m += NGW) {
            const int b = m / SEQ;
            const f32x4* xr = (const f32x4*)(x + (size_t)m * DM) + lane;
            const f32x4* sh = (const f32x4*)(mod + b * 6144) + lane; const f32x4* sc = (const f32x4*)(mod + b * 6144 + 1024) + lane;
            f32x4 v[4]; float s = 0.f;
#pragma unroll
            for (int j = 0; j < 4; ++j) { v[j] = xr[64 * j]; s += (v[j].x + v[j].y) + (v[j].z + v[j].w); }
            const float mean = wave_sum(s) * (1.f / DM); float s2 = 0.f;
#pragma unroll
            for (int j = 0; j < 4; ++j) { v[j] = v[j] - mean; s2 += (v[j].x * v[j].x + v[j].y * v[j].y) + (v[j].z * v[j].z + v[j].w * v[j].w); }
            const float rstd = 1.f / sqrtf(wave_sum(s2) * (1.f / DM) + LN_EPS);
            unsigned long long* o8 = (unsigned long long*)(H + (size_t)m * DM) + lane;
#pragma unroll
            for (int j = 0; j < 4; ++j) { const f32x4 a = sc[64 * j], d = sh[64 * j]; const f32x4 h = v[j] * rstd * (a + 1.f) + d;
                o8[64 * j] = (unsigned long long)pk2(h.x, h.y) | ((unsigned long long)pk2(h.z, h.w) << 32); }
        }
    }
    SEAM(1);

    if (IN(2)) {
        const int wm = wave >> 1, wn = wave & 1;
        for (int u = bid; u < 64 * 9; u += G) {
            const int pm = u / 9, pn = u % 9;
            const int m0 = pm * 256 + wm * 64;
            const bf16* arow[4];
#pragma unroll
            for (int i = 0; i < 4; ++i) arow[i] = H + (size_t)(m0 + 16 * i + (lane & 15)) * DM;
#pragma unroll
            for (int half = 0; half < 2; ++half) {
                const int n0 = pn * 256 + wn * 128 + half * 64;
                const bf16* brow[4];
#pragma unroll
                for (int j = 0; j < 4; ++j) brow[j] = WinT + (size_t)(n0 + 16 * j + (lane & 15)) * DM;
                f32x4 acc[4][4];
                wave_gemm64(arow, brow, DM, acc, lane);
                const float sc = (n0 < C_DK) ? C2 : 1.f;
#pragma unroll
                for (int i = 0; i < 4; ++i)
#pragma unroll
                    for (int j = 0; j < 4; ++j)
#pragma unroll
                        for (int r = 0; r < 4; ++r)
                            PROJ[(size_t)(m0 + 16 * i + 4 * (lane >> 4) + r) * INC + n0 + 16 * j + (lane & 15)] = (bf16)f2bf(acc[i][j][r] * sc);
            }
        }
    }
    SEAM(2);

    if (IN(3)) {
        const float* qg = args.in[I_QNG]; const float* kg = args.in[I_KNG];
        const int hl = lane >> 5, p = lane & 31;
        for (int m = gw; m < T; m += NGW) {
            const int s = m % SEQ; const float pos = (p < 16) ? (float)(s / 64) : (float)(s % 64);
            const float freq = powf(10000.f, -(float)(2 * (p & 15)) / 32.f);
            const float ang = pos * freq; const float cs = cosf(ang), sn = sinf(ang);
#pragma unroll
            for (int it = 0; it < 5; ++it) {
                const int hd = it * 2 + hl;
                const bool isq = hd < 8;
                bf16* ptr = PROJ + (size_t)m * INC + (isq ? C_GQ + hd * 64 : C_GK + (hd - 8) * 64) + 2 * p;
                const unsigned w = *(const unsigned*)ptr;
                const float x1 = bf2f((unsigned short)(w & 0xffffu)), x2 = bf2f((unsigned short)(w >> 16));
                const float ss = half_sum(x1 * x1 + x2 * x2);
                const float r = 1.f / sqrtf(ss * (1.f / 64.f) + RMS_EPS);
                const float* g = isq ? qg : kg;
                const float y1 = x1 * r * g[2 * p], y2 = x2 * r * g[2 * p + 1];
                float o1 = y1 * cs - y2 * sn, o2 = y1 * sn + y2 * cs;
                if (isq) { o1 *= C2; o2 *= C2; }
                *(unsigned*)ptr = pk2(o1, o2);
            }
        }
    }
    SEAM(3);

    if (IN(4)) {
        LAS float* Kt = (LAS float*)lds;
        LAS float* Vt = (LAS float*)(lds + 16384);
        LAS float* tb = (LAS float*)(lds + 49152);
        const float* relb = args.in[I_RELB];
        float lam;
        { float d1 = 0.f, d2 = 0.f;
          for (int i = 0; i < 64; ++i) { d1 += args.in[I_LQ1][i] * args.in[I_LK1][i]; d2 += args.in[I_LQ2][i] * args.in[I_LK2][i]; }
          lam = expf(d1) - expf(d2) + LAMBDA_INIT; }
        float* scratch = out;
        for (int u = bid; u < 384; u += G) {
            const bool diff = u < 128;
            int b, h, qb;
            if (diff) { b = u / 16; h = (u / 4) % 4; qb = u % 4; } else { const int g2 = u - 128; b = g2 / 32; h = (g2 / 4) % 8; qb = g2 % 4; }
            const int qpos = qb * 512 + tid; const size_t trow = (size_t)b * SEQ + qpos;
            if (diff) {
                __syncthreads();
                for (int i = tid; i < 4096; i += NTHR) { const int rel = i - 2048; const int n = rel < 0 ? -rel : rel;
                    int bk; if (n < 8) bk = n; else { const int l2 = 31 - __clz(n * n); bk = 8 + l2 - 6; if (bk > 15) bk = 15; }
                    if (rel > 0) bk += 16;
                    tb[i] = relb[bk * 4 + h] * LOG2E; }
            }
            const int npass = diff ? 4 : 1;
#pragma unroll 1
            for (int ps = 0; ps < npass; ++ps) {
                const int cm = ps >> 1, vh = ps & 1;
                const int qcol = diff ? (C_DQ + h * 128 + cm * 64) : (C_GQ + h * 64);
                const int kcol = diff ? (C_DK + h * 128 + cm * 64) : (C_GK + (h >> 2) * 64);
                const int vcol = diff ? (C_DV + h * 128 + vh * 64) : (C_GV + (h >> 2) * 64);
                float q[64];
#pragma unroll
                for (int d8 = 0; d8 < 8; ++d8) { const bf16x8 qv = *(const bf16x8*)(PROJ + trow * INC + qcol + d8 * 8);
#pragma unroll
                    for (int j = 0; j < 8; ++j) q[d8 * 8 + j] = bf2f((unsigned short)qv[j]); }
                float o[64];
#pragma unroll
                for (int e = 0; e < 64; ++e) o[e] = 0.f;
                float mx = -1e30f, l = 0.f;
#pragma unroll 1
                for (int kt = 0; kt < SEQ / 64; ++kt) {
                    __syncthreads();
                    { const int key = tid >> 3, d0 = (tid & 7) * 8; const size_t krow = (size_t)b * SEQ + kt * 64 + key;
                      const bf16x8 kv = *(const bf16x8*)(PROJ + krow * INC + kcol + d0);
                      const bf16x8 vv = *(const bf16x8*)(PROJ + krow * INC + vcol + d0);
#pragma unroll
                      for (int j = 0; j < 8; ++j) { Kt[key * 64 + d0 + j] = bf2f((unsigned short)kv[j]); Vt[key * 64 + d0 + j] = bf2f((unsigned short)vv[j]); } }
                    __syncthreads();
#pragma unroll 1
                    for (int j = 0; j < 64; ++j) {
                        float s = 0.f;
#pragma unroll
                        for (int d = 0; d < 64; ++d) s += q[d] * Kt[j * 64 + d];
                        if (diff) s += tb[kt * 64 + j - qpos + 2048];
                        if (s > mx) { const float f = exp2f(mx - s); l *= f;
#pragma unroll
                            for (int e = 0; e < 64; ++e) o[e] *= f;
                            mx = s; }
                        const float pp = exp2f(s - mx); l += pp;
#pragma unroll
                        for (int e = 0; e < 64; ++e) o[e] += pp * Vt[j * 64 + e];
                    }
                }
                const float il = 1.f / l;
                if (!diff) {
#pragma unroll
                    for (int e = 0; e < 64; e += 2) *(unsigned*)(MIX + trow * DM + 512 + h * 64 + e) = pk2(o[e] * il, o[e + 1] * il);
                } else if (cm == 0) {
#pragma unroll
                    for (int e = 0; e < 64; ++e) scratch[((size_t)bid * 128 + vh * 64 + e) * NTHR + tid] = o[e] * il;
                } else {
#pragma unroll
                    for (int e = 0; e < 64; ++e) { float* sp = scratch + ((size_t)bid * 128 + vh * 64 + e) * NTHR + tid; *sp = *sp - lam * (o[e] * il); }
                }
            }
            if (diff) {
                float ss = 0.f;
                for (int e = 0; e < 128; ++e) { const float d = scratch[((size_t)bid * 128 + e) * NTHR + tid]; ss += d * d; }
                const float r = (1.f - LAMBDA_INIT) / sqrtf(ss * (1.f / 128.f) + RMS_EPS);
                const float* sg = args.in[I_SUBLN];
                for (int e = 0; e < 128; e += 2) { const float d0 = scratch[((size_t)bid * 128 + e) * NTHR + tid], d1 = scratch[((size_t)bid * 128 + e + 1) * NTHR + tid];
                    *(unsigned*)(MIX + trow * DM + h * 128 + e) = pk2(d0 * r * sg[e], d1 * r * sg[e + 1]); }
            }
        }
    }
    SEAM(4);

    if (IN(5)) {
        const int wm = wave >> 1, wn = wave & 1;
        for (int u = bid; u < 64 * 4; u += G) {
            const int pm = u / 4, pn = u % 4;
            const int m0 = pm * 256 + wm * 64; const int b = m0 / SEQ;
            const bf16* arow[4];
#pragma unroll
            for (int i = 0; i < 4; ++i) arow[i] = MIX + (size_t)(m0 + 16 * i + (lane & 15)) * DM;
#pragma unroll
            for (int half = 0; half < 2; ++half) {
                const int n0 = pn * 256 + wn * 128 + half * 64;
                const bf16* brow[4];
#pragma unroll
                for (int j = 0; j < 4; ++j) brow[j] = WoutT + (size_t)(n0 + 16 * j + (lane & 15)) * DM;
                f32x4 acc[4][4];
                wave_gemm64(arow, brow, DM, acc, lane);
#pragma unroll
                for (int j = 0; j < 4; ++j) { const int col = n0 + 16 * j + (lane & 15); const float g1 = 1.f + mod[b * 6144 + 2048 + col];
#pragma unroll
                    for (int i = 0; i < 4; ++i)
#pragma unroll
                        for (int r = 0; r < 4; ++r) { const size_t idx = (size_t)(m0 + 16 * i + 4 * (lane >> 4) + r) * DM + col;
                            out[idx] = ALPHA * x[idx] + g1 * acc[i][j][r]; } }
            }
        }
    }
    SEAM(5);

    if (IN(6)) {
        const float* g1v = args.in[I_LN1G]; const float* b1v = args.in[I_LN1B];
        const float* wrg = args.in[I_WRG]; const float* brg = args.in[I_BRG]; const float* wre = args.in[I_WRE]; const float* bre = args.in[I_BRE];
        for (int m = gw; m < T; m += NGW) {
            const int b = m / SEQ;
            f32x4* yr = (f32x4*)(out + (size_t)m * DM) + lane;
            f32x4 v[4]; float s = 0.f;
#pragma unroll
            for (int j = 0; j < 4; ++j) { v[j] = yr[64 * j]; s += (v[j].x + v[j].y) + (v[j].z + v[j].w); }
            float mean = wave_sum(s) * (1.f / DM); float s2 = 0.f;
#pragma unroll
            for (int j = 0; j < 4; ++j) { v[j] = v[j] - mean; s2 += (v[j].x * v[j].x + v[j].y * v[j].y) + (v[j].z * v[j].z + v[j].w * v[j].w); }
            float rstd = 1.f / sqrtf(wave_sum(s2) * (1.f / DM) + LN_EPS);
            s = 0.f;
#pragma unroll
            for (int j = 0; j < 4; ++j) { const f32x4 gg = ((const f32x4*)g1v)[64 * j + lane], bb = ((const f32x4*)b1v)[64 * j + lane];
                v[j] = v[j] * rstd * gg + bb; yr[64 * j] = v[j]; s += (v[j].x + v[j].y) + (v[j].z + v[j].w); }
            mean = wave_sum(s) * (1.f / DM); s2 = 0.f;
#pragma unroll
            for (int j = 0; j < 4; ++j) { v[j] = v[j] - mean; s2 += (v[j].x * v[j].x + v[j].y * v[j].y) + (v[j].z * v[j].z + v[j].w * v[j].w); }
            rstd = 1.f / sqrtf(wave_sum(s2) * (1.f / DM) + LN_EPS);
            const f32x4* sh = (const f32x4*)(mod + b * 6144 + 3072) + lane; const f32x4* sc = (const f32x4*)(mod + b * 6144 + 4096) + lane;
            unsigned long long* o8 = (unsigned long long*)(H + (size_t)m * DM) + lane;
#pragma unroll
            for (int j = 0; j < 4; ++j) { v[j] = v[j] * rstd * (sc[64 * j] + 1.f) + sh[64 * j];
                o8[64 * j] = (unsigned long long)pk2(v[j].x, v[j].y) | ((unsigned long long)pk2(v[j].z, v[j].w) << 32); }
            float lg[36];
#pragma unroll
            for (int o = 0; o < 36; ++o) lg[o] = 0.f;
#pragma unroll
            for (int j = 0; j < 4; ++j)
#pragma unroll
                for (int cc = 0; cc < 4; ++cc) { const int col = 4 * lane + 256 * j + cc; const float hv = v[j][cc];
                    const f32x4 wg = *(const f32x4*)(wrg + col * 4);
#pragma unroll
                    for (int o = 0; o < 4; ++o) lg[o] += hv * wg[o];
#pragma unroll
                    for (int g = 0; g < 4; ++g) { const f32x4 w0 = *(const f32x4*)(wre + ((size_t)g * DM + col) * 8), w1 = *(const f32x4*)(wre + ((size_t)g * DM + col) * 8 + 4);
#pragma unroll
                        for (int o = 0; o < 4; ++o) { lg[4 + g * 8 + o] += hv * w0[o]; lg[4 + g * 8 + 4 + o] += hv * w1[o]; } } }
#pragma unroll
            for (int o = 0; o < 36; ++o) lg[o] = wave_sum(lg[o]);
            if (lane == 0) {
                volatile LAS float* wl = (volatile LAS float*)(lds + 131072 + 8192 + wave * 256);
                float gl[4]; int gs = 0;
#pragma unroll
                for (int o = 0; o < 4; ++o) gl[o] = lg[o] + brg[o];
                float gmax = gl[0];
#pragma unroll
                for (int o = 1; o < 4; ++o) if (gl[o] > gmax) { gmax = gl[o]; gs = o; }
                float den = 0.f;
#pragma unroll
                for (int o = 0; o < 4; ++o) den += expf(gl[o] - gmax);
                const float pg = 1.f / den;
                float el[8];
#pragma unroll
                for (int o = 0; o < 32; ++o) wl[o] = lg[4 + o];
#pragma unroll
                for (int o = 0; o < 8; ++o) el[o] = wl[gs * 8 + o] + bre[gs * 8 + o];
                int i1 = 0; float v1 = el[0];
#pragma unroll
                for (int o = 1; o < 8; ++o) if (el[o] > v1) { v1 = el[o]; i1 = o; }
                int i2 = -1; float v2 = -3.0e38f;
#pragma unroll
                for (int o = 0; o < 8; ++o) if (o != i1 && (i2 < 0 || el[o] > v2)) { v2 = el[o]; i2 = o; }
                const float ex = expf(v2 - v1);
                const float wa = pg / (1.f + ex), wb = pg * ex / (1.f + ex);
                const int e1 = gs * 8 + i1, e2 = gs * 8 + i2;
                const int p1 = (int)atomicAdd(ctl + CW_CNT + 64 * e1, 1u); const int p2 = (int)atomicAdd(ctl + CW_CNT + 64 * e2, 1u);
                list[(size_t)e1 * T + p1] = m; list[(size_t)e2 * T + p2] = m;
                tokE[2 * m] = e1; tokE[2 * m + 1] = e2; tokW[2 * m] = wa; tokW[2 * m + 1] = wb; tokP[2 * m] = p1; tokP[2 * m + 1] = p2;
            }
        }
    }
    SEAM(6);

    LAS int* toff = (LAS int*)(lds + 131072 + 4096);
    if (hi > 7) {
        __syncthreads();
        if (tid == 0) { int acc = 0; for (int e = 0; e < NEXP; ++e) { const int cnt = (int)__hip_atomic_load(ctl + CW_CNT + 64 * e, __ATOMIC_RELAXED, __HIP_MEMORY_SCOPE_AGENT);
            toff[e] = acc; toff[64 + e] = cnt; acc += (cnt + 255) >> 8; } toff[32] = acc; }
        __syncthreads();
    }

    if (IN(7)) {
        const int wm = wave >> 1, wn = wave & 1;
        const int ntile = toff[32];
        for (int u = bid; u < ntile * 4; u += G) {
            const int tile = u >> 2, pn = u & 3;
            int e = 0;
            for (int k = 1; k < NEXP; ++k) if (toff[k] <= tile) e = k;
            const int cnt = toff[64 + e]; const int r0 = (tile - toff[e]) * 256 + wm * 64;
            const bf16* arow[4];
#pragma unroll
            for (int i = 0; i < 4; ++i) { const int rr = r0 + 16 * i + (lane & 15); const int tok = (rr < cnt) ? list[(size_t)e * T + rr] : 0; arow[i] = H + (size_t)tok * DM; }
            const bf16* Wt = WguT + (size_t)e * 1024 * 1024 + (size_t)pn * 256 * 1024;
            const bf16* brow[4];
            f32x4 accg[4][4], accu[4][4];
#pragma unroll
            for (int j = 0; j < 4; ++j) brow[j] = Wt + (size_t)(wn * 64 + 16 * j + (lane & 15)) * DM;
            wave_gemm64(arow, brow, DM, accg, lane);
#pragma unroll
            for (int j = 0; j < 4; ++j) brow[j] = Wt + (size_t)(128 + wn * 64 + 16 * j + (lane & 15)) * DM;
            wave_gemm64(arow, brow, DM, accu, lane);
            const size_t slot0 = (size_t)tile * 256 + wm * 64;
#pragma unroll
            for (int i = 0; i < 4; ++i)
#pragma unroll
                for (int j = 0; j < 4; ++j)
#pragma unroll
                    for (int r = 0; r < 4; ++r) { const float gt = accg[i][j][r], up = accu[i][j][r];
                        HID[(slot0 + 16 * i + 4 * (lane >> 4) + r) * DEXP + pn * 128 + wn * 64 + 16 * j + (lane & 15)] = (bf16)f2bf(gt / (1.f + __expf(-gt)) * up); }
        }
    }
    SEAM(7);

    if (IN(8)) {
        const int wm = wave >> 1, wn = wave & 1;
        const int ntile = toff[32];
        for (int u = bid; u < ntile * 4; u += G) {
            const int tile = u >> 2, pn = u & 3;
            int e = 0;
            for (int k = 1; k < NEXP; ++k) if (toff[k] <= tile) e = k;
            const size_t slot0 = (size_t)tile * 256 + wm * 64;
            const bf16* arow[4];
#pragma unroll
            for (int i = 0; i < 4; ++i) arow[i] = HID + (slot0 + 16 * i + (lane & 15)) * DEXP;
#pragma unroll
            for (int half = 0; half < 2; ++half) {
                const int n0 = pn * 256 + wn * 128 + half * 64;
                const bf16* brow[4];
#pragma unroll
                for (int j = 0; j < 4; ++j) brow[j] = WdT + (size_t)e * 1024 * 512 + (size_t)(n0 + 16 * j + (lane & 15)) * DEXP;
                f32x4 acc[4][4];
                wave_gemm64(arow, brow, DEXP, acc, lane);
#pragma unroll
                for (int i = 0; i < 4; ++i)
#pragma unroll
                    for (int j = 0; j < 4; ++j)
#pragma unroll
                        for (int r = 0; r < 4; ++r)
                            YS[(slot0 + 16 * i + 4 * (lane >> 4) + r) * DM + n0 + 16 * j + (lane & 15)] = (bf16)f2bf(acc[i][j][r]);
            }
        }
    }
    SEAM(8);

    if (IN(9)) {
        const float* g2v = args.in[I_LN2G]; const float* b2v = args.in[I_LN2B];
        for (int m = gw; m < T; m += NGW) {
            const int b = m / SEQ;
            const int e1 = tokE[2 * m], e2 = tokE[2 * m + 1]; const float wa = tokW[2 * m], wb = tokW[2 * m + 1];
            const size_t sa = (size_t)toff[e1] * 256 + tokP[2 * m], sb = (size_t)toff[e2] * 256 + tokP[2 * m + 1];
            f32x4* xr = (f32x4*)(out + (size_t)m * DM) + lane;
            const u32x2* ya = (const u32x2*)(YS + sa * DM) + lane; const u32x2* yb = (const u32x2*)(YS + sb * DM) + lane;
            const f32x4* gg2 = (const f32x4*)(mod + b * 6144 + 5120) + lane;
            f32x4 v[4]; float s = 0.f;
#pragma unroll
            for (int j = 0; j < 4; ++j) { const f32x4 xv = xr[64 * j]; const u32x2 a = ya[64 * j], bq = yb[64 * j]; const f32x4 g2 = gg2[64 * j] + 1.f;
                f32x4 fa, fb;
                fa.x = bf2f((unsigned short)(a.x & 0xffffu)); fa.y = bf2f((unsigned short)(a.x >> 16)); fa.z = bf2f((unsigned short)(a.y & 0xffffu)); fa.w = bf2f((unsigned short)(a.y >> 16));
                fb.x = bf2f((unsigned short)(bq.x & 0xffffu)); fb.y = bf2f((unsigned short)(bq.x >> 16)); fb.z = bf2f((unsigned short)(bq.y & 0xffffu)); fb.w = bf2f((unsigned short)(bq.y >> 16));
                v[j] = xv * ALPHA + g2 * (fa * wa + fb * wb); s += (v[j].x + v[j].y) + (v[j].z + v[j].w); }
            const float mean = wave_sum(s) * (1.f / DM); float s2 = 0.f;
#pragma unroll
            for (int j = 0; j < 4; ++j) { v[j] = v[j] - mean; s2 += (v[j].x * v[j].x + v[j].y * v[j].y) + (v[j].z * v[j].z + v[j].w * v[j].w); }
            const float rstd = 1.f / sqrtf(wave_sum(s2) * (1.f / DM) + LN_EPS);
#pragma unroll
            for (int j = 0; j < 4; ++j) { const f32x4 gg = ((const f32x4*)g2v)[64 * j + lane], bb = ((const f32x4*)b2v)[64 * j + lane]; xr[64 * j] = v[j] * rstd * gg + bb; }
        }
    }
#undef IN
#undef SEAM
}

extern "C" void kernel_launch(void* const* d_in, const int* in_sizes, int n_in, void* d_out, int out_size, void* d_ws, size_t ws_size, hipStream_t stream) {
    static int grid = 0;
    if (grid == 0) {
        if (n_in != 25 || out_size != T * DM || ws_size < WS_END) { fprintf(stderr, "kernel_launch: unexpected shapes (n_in %d out %d ws %zu)\n", n_in, out_size, ws_size); grid = -1; return; }
        int dev = 0, cus = 0, per_cu = 0;
        if (hipGetDevice(&dev) != hipSuccess || hipDeviceGetAttribute(&cus, hipDeviceAttributeMultiprocessorCount, dev) != hipSuccess) { grid = -1; return; }
        if (hipFuncSetAttribute((const void*)fwd, hipFuncAttributeMaxDynamicSharedMemorySize, LDS_BYTES) != hipSuccess) { fprintf(stderr, "kernel_launch: hipFuncSetAttribute failed\n"); grid = -1; return; }
        if (hipOccupancyMaxActiveBlocksPerMultiprocessor(&per_cu, (const void*)fwd, NTHR, LDS_BYTES) != hipSuccess || per_cu < 1) { fprintf(stderr, "kernel_launch: occupancy query says %d\n", per_cu); }
        (void)hipGetLastError();
        grid = cus;
    }
    if (grid < 0) return;
    (void)hipMemsetAsync((char*)d_ws + WS_CTL, 0, CTL_ZERO_BYTES, stream);
    Args a{};
    for (int i = 0; i < 25; ++i) a.in[i] = (const float*)d_in[i];
    a.out = (float*)d_out; a.ws = (unsigned char*)d_ws; a.pad = 0;
    if (MK_N_LAUNCHES == 1) {
        a.ph_lo = 0; a.ph_hi = NPH; a.li = 0;
        hipLaunchKernelGGL(fwd, dim3(grid), dim3(NTHR), LDS_BYTES, stream, a);
    } else {
        for (int p = 0; p < NPH; ++p) { a.ph_lo = p; a.ph_hi = p + 1; a.li = p; hipLaunchKernelGGL(fwd, dim3(grid), dim3(NTHR), LDS_BYTES, stream, a); }
    }
}
```

```cpp
#include <hip/hip_runtime.h>
#include <cstdio>
#include <cstdint>
#include <hip/hip_bf16.h>

#ifndef MK_N_LAUNCHES
#define MK_N_LAUNCHES 1
#endif

#define GAS __attribute__((address_space(1)))
#define LAS __attribute__((address_space(3)))
typedef unsigned short bf16;
typedef short bf16x8 __attribute__((ext_vector_type(8)));
typedef float f32x4 __attribute__((ext_vector_type(4)));
typedef unsigned u32x4 __attribute__((ext_vector_type(4)));
typedef unsigned u32x2 __attribute__((ext_vector_type(2)));

constexpr int NB = 8, SEQ = 2048, DM = 1024, T = NB * SEQ;
constexpr int INC = 2304;
constexpr int C_DQ = 0, C_DK = 512, C_DV = 1024, C_GQ = 1536, C_GK = 2048, C_GV = 2176;
constexpr int NEXP = 32, DEXP = 512;
constexpr float LN_EPS = 1e-5f, RMS_EPS = 1e-6f;
constexpr float ALPHA = 1.189207115002721f;
constexpr float LAMBDA_INIT = 0.2f;
constexpr float LOG2E = 1.4426950408889634f;
constexpr float C2 = 0.125f * LOG2E;
constexpr int NWAVES = 8, NTHR = 512;
constexpr int NPH = 10;

constexpr size_t MiB = 1u << 20;
constexpr size_t WS_CTL = 0, CTL_ZERO_BYTES = 1 * MiB;
constexpr size_t WS_MOD = 1 * MiB;
constexpr size_t WS_TOKE = 2 * MiB;
constexpr size_t WS_TOKW = 2 * MiB + 256 * 1024;
constexpr size_t WS_TOKP = 2 * MiB + 512 * 1024;
constexpr size_t WS_LIST = 4 * MiB;
constexpr size_t WS_WIN = 8 * MiB;
constexpr size_t WS_WOUT = 14 * MiB;
constexpr size_t WS_WGU = 16 * MiB;
constexpr size_t WS_WD = 80 * MiB;
constexpr size_t WS_H = 112 * MiB;
constexpr size_t WS_PROJ = 144 * MiB;
constexpr size_t WS_MIX = 216 * MiB;
constexpr size_t WS_HID = 216 * MiB;
constexpr size_t WS_YS = 112 * MiB;
constexpr size_t WS_END = 256 * MiB;
constexpr int MAXSLOT = 40960;
constexpr int CW_BAR = 4096;
constexpr int CW_CNT = 16384;

__device__ __forceinline__ unsigned f2bf(float f) { unsigned u = __builtin_bit_cast(unsigned, f); return (u + 0x7fffu + ((u >> 16) & 1u)) >> 16; }
__device__ __forceinline__ unsigned pk2(float lo, float hi) { return f2bf(lo) | (f2bf(hi) << 16); }
__device__ __forceinline__ float bf2f(unsigned short u) { return __builtin_bit_cast(float, (unsigned)u << 16); }
__device__ __forceinline__ float wave_sum(float v) {
#pragma unroll
    for (int o = 1; o < 64; o <<= 1) v += __shfl_xor(v, o);
    return v;
}
__device__ __forceinline__ float half_sum(float v) {
#pragma unroll
    for (int o = 1; o < 32; o <<= 1) v += __shfl_xor(v, o);
    return v;
}

#define XB_TMO      128
#define XB_XCNT(j)  (256  + 64 * (j))
#define XB_XSUB(j)  (1280 + 64 * (j))
#define XB_XGEN(j)  (2304 + 64 * (j))
#define XB_TOP      3328
#define XB_TOPGEN   3392
#define XCD_BAR_WORDS 3456
#define XB_SPIN_CAP (1u << 18)
__device__ __forceinline__ unsigned xb_ld(unsigned* p)              { return __hip_atomic_load(p, __ATOMIC_RELAXED, __HIP_MEMORY_SCOPE_AGENT); }
__device__ __forceinline__ unsigned xb_add(unsigned* p, unsigned v) { return __hip_atomic_fetch_add(p, v, __ATOMIC_RELAXED, __HIP_MEMORY_SCOPE_AGENT); }
__device__ __forceinline__ unsigned xb_xcc_id() { return (unsigned)__builtin_amdgcn_s_getreg((3 << 11) | 20) & 0xFu; }
#define XB_SPIN(cond, bar) do { unsigned _sp = 0; while (cond) { __builtin_amdgcn_s_sleep(1); \
    if ((++_sp & 255u) == 0u) { if (xb_ld(&(bar)[XB_TMO])) break; if (_sp > XB_SPIN_CAP) { atomicAdd(&(bar)[XB_TMO], 1u); break; } } } } while (0)
struct XcdBarrier { unsigned* bar; unsigned x; volatile LAS unsigned* st; };
__device__ __forceinline__ XcdBarrier xcd_barrier_post(unsigned* bar, volatile LAS unsigned* st) {
    XcdBarrier b; b.bar = bar; b.x = xb_xcc_id(); b.st = st;
    if (threadIdx.x == 0) (void)xb_add(&bar[XB_XCNT(b.x)], 1u);
    return b;
}
__device__ __forceinline__ void xcd_barrier_complete(unsigned* bar, unsigned x, unsigned& nloc, unsigned& nx) {
    const unsigned G = gridDim.x * gridDim.y * gridDim.z;
    unsigned sum, cnt, mine, sp = 0u;
    for (;;) {
        sum = 0u; cnt = 0u; mine = 0u;
#pragma unroll
        for (unsigned j = 0; j < 16; ++j) { const unsigned c = xb_ld(&bar[XB_XCNT(j)]); sum += c; cnt += (c > 0u) ? 1u : 0u; mine = (j == x) ? c : mine; }
        if (sum == G) break;
        __builtin_amdgcn_s_sleep(1);
        if ((++sp & 255u) == 0u) { if (xb_ld(&bar[XB_TMO])) break; if (sp > XB_SPIN_CAP) { atomicAdd(&bar[XB_TMO], 1u); break; } }
    }
    nloc = mine > 0u ? mine : 1u; nx = cnt > 0u ? cnt : 1u;
}
__device__ __forceinline__ void xcd_barrier(const XcdBarrier& b) {
    asm volatile("s_waitcnt vmcnt(0)" ::: "memory");
    __syncthreads();
    if (threadIdx.x == 0) {
        unsigned* bar = b.bar;
        __builtin_amdgcn_s_waitcnt(0);
        unsigned nloc = b.st[0], nx = b.st[1];
        if (nloc == 0u) { xcd_barrier_complete(bar, b.x, nloc, nx); b.st[0] = nloc; b.st[1] = nx; }
        const unsigned old = xb_add(&bar[XB_XSUB(b.x)], 1u);
        const unsigned gen = old / nloc;
        if (old + 1u == (gen + 1u) * nloc) {
            __builtin_amdgcn_fence(__ATOMIC_RELEASE, "agent");
            asm volatile("s_waitcnt vmcnt(0)" ::: "memory");
            const unsigned og = xb_add(&bar[XB_TOP], 1u);
            const unsigned tg = og / nx;
            if (og + 1u == (tg + 1u) * nx) xb_add(&bar[XB_TOPGEN], 1u);
            else XB_SPIN(xb_ld(&bar[XB_TOPGEN]) == tg, bar);
            __builtin_amdgcn_fence(__ATOMIC_ACQUIRE, "agent");
            xb_add(&bar[XB_XGEN(b.x)], 1u);
            asm volatile("s_waitcnt vmcnt(0)" ::: "memory");
        } else {
            XB_SPIN(xb_ld(&bar[XB_XGEN(b.x)]) == gen, bar);
            __builtin_amdgcn_fence(__ATOMIC_ACQUIRE, "agent");
            asm volatile("s_waitcnt vmcnt(0)" ::: "memory");
        }
    }
    __syncthreads();
}

struct Args {
    const float* in[25]; float* out; unsigned char* ws; int ph_lo, ph_hi, li, pad;
};
enum { I_X = 0, I_C, I_WADA, I_BADA, I_WIN, I_LQ1, I_LK1, I_LQ2, I_LK2, I_SUBLN, I_QNG, I_KNG, I_RELB, I_WOUT, I_LN1G, I_LN1B,
       I_WRG, I_BRG, I_WRE, I_BRE, I_WGATE, I_WUP, I_WDOWN, I_LN2G, I_LN2B };

constexpr int LDS_BYTES = 147456;
constexpr int MISC_OFF = 131072 + 320;

__device__ __forceinline__ void wave_gemm64(const bf16* (&arow)[4], const bf16* (&brow)[4], int K, f32x4 (&acc)[4][4], int lane) {
    const int kq = (lane >> 4) * 8;
#pragma unroll
    for (int i = 0; i < 4; ++i)
#pragma unroll
        for (int j = 0; j < 4; ++j) acc[i][j] = (f32x4){0.f, 0.f, 0.f, 0.f};
    for (int k0 = 0; k0 < K; k0 += 32) {
        bf16x8 a[4], b[4];
#pragma unroll
        for (int i = 0; i < 4; ++i) a[i] = *(const bf16x8*)(arow[i] + k0 + kq);
#pragma unroll
        for (int j = 0; j < 4; ++j) b[j] = *(const bf16x8*)(brow[j] + k0 + kq);
#pragma unroll
        for (int i = 0; i < 4; ++i)
#pragma unroll
            for (int j = 0; j < 4; ++j) acc[i][j] = __builtin_amdgcn_mfma_f32_16x16x32_bf16(a[i], b[j], acc[i][j], 0, 0, 0);
    }
}


namespace pg8 {
constexpr int BM = 256, BK = 64, HALF = 128, HTB = HALF * BK * 2, STAGE_BYTES = 8 * HTB, NXCD = 8, WGM = 8;
__host__ __device__ __forceinline__ int lds_byte(int r, int c) { const int st = (r >> 4) * 2 + (c >> 5), rr = r & 15, cc = c & 31, ob = rr * 64 + cc * 2; return st * 1024 + (ob ^ (((ob >> 9) & 1) << 5)); }
__host__ __device__ __forceinline__ void stage_rc(int b, int& R, int& C) { const int st = b / 1024, sb = b % 1024, swz = sb ^ (((sb >> 9) & 1) << 5); R = (st >> 1) * 16 + swz / 64; C = (st & 1) * 32 + (swz % 64) / 2; }
__host__ __device__ __forceinline__ int perm32(int rho) { const int n = rho >> 4, i = rho & 15; return 8 * (i >> 2) + 4 * n + (i & 3); }
struct Unit { int pm, pn; };
struct Gemm { const bf16* A; const bf16* Bt; int K; };
struct StaticOrder {
    int nM, nN, nwg, G, c;
    __device__ void init(int M, int N, int G_, int c_) { nM = M / BM; nN = N / BM; nwg = nM * nN; G = G_; c = c_; }
    __device__ bool next(int i, Unit& u) const {
        const long L = (long)i * G + c; if (L >= nwg) return false;
        int wgid = (int)L; { const int q = nwg / NXCD, r = nwg % NXCD, xcd = wgid % NXCD, off = wgid / NXCD; wgid = (xcd < r ? xcd * (q + 1) : r * (q + 1) + (xcd - r) * q) + off; }
        const int nig = WGM * nN, gid = wgid / nig, fm = gid * WGM, gsz = (nM - fm) < WGM ? (nM - fm) : WGM;
        u.pm = fm + ((wgid % nig) % gsz); u.pn = (wgid % nig) / gsz; return true;
    }
};
__device__ __forceinline__ unsigned cvt_pk_bf16(float lo, float hi) { unsigned r; asm volatile("v_cvt_pk_bf16_f32 %0, %1, %2" : "=v"(r) : "v"(lo), "v"(hi)); return r; }

template <class Epi, class Sched, bool ALIGN_EPI, bool GATHER>
__device__ __forceinline__ void gemm_phase(LAS unsigned char* lds, const Gemm g, const Sched& S, const Epi& E, const LAS int* tokTab) {
    const int tid = threadIdx.x, wid = __builtin_amdgcn_readfirstlane(tid >> 6), lane = tid & 63, wr = wid >> 2, wc = wid & 3, fr = lane & 15, fq = lane >> 4;
    const int K = g.K, nt = K / BK;
    unsigned voffA[2], voffB[2];
#pragma unroll
    for (int i = 0; i < 2; ++i) { int R, C; stage_rc(tid * 16 + i * 8192, R, C); const int Rb = Epi::PERM ? ((R & ~31) + perm32(R & 31)) : R;
        voffA[i] = (unsigned)(R * K + C) * 2u; voffB[i] = (unsigned)(Rb * K + C) * 2u; }
    const size_t kstep = (size_t)(BK * 2);
    const size_t hstep = (size_t)HALF * K * 2;
    const size_t tstep = 2 * hstep;
    const unsigned ldsw = (unsigned)wid * 1024u;
    const int aoff = lds_byte(wr * 64 + fr, fq * 8), boff = lds_byte(wc * 32 + fr, fq * 8);
#define PG8_SA(b, h) (((b) * 2 + (h)) * HTB)
#define PG8_SB(b, h) ((4 + (b) * 2 + (h)) * HTB)
#define PG8_STAGE(bufoff, gbase, voff) do { _Pragma("unroll") for (int _i = 0; _i < 2; ++_i) \
        __builtin_amdgcn_global_load_lds((const unsigned*)((const char*)(gbase) + (voff)[_i]), (LAS unsigned*)(lds + (bufoff) + ldsw + _i * 8192), 16, 0, 0); } while (0)
#define PG8_STAGE_A(bufoff, kptr, h, vs) do { if constexpr (GATHER) { PG8_STAGE(bufoff, kptr, (vs)[h]); } else { PG8_STAGE(bufoff, (kptr) + (h) * hstep, voffA); } } while (0)
#define PG8_LDA(dst, b, h) do { _Pragma("unroll") for (int m = 0; m < 4; ++m) _Pragma("unroll") for (int k = 0; k < 2; ++k) dst[m][k] = *(const LAS bf16x8*)(lds + PG8_SA(b, h) + aoff + m * 2048 + k * 1024); } while (0)
#define PG8_LDB(dst, b, h) do { _Pragma("unroll") for (int n = 0; n < 2; ++n) _Pragma("unroll") for (int k = 0; k < 2; ++k) dst[n][k] = *(const LAS bf16x8*)(lds + PG8_SB(b, h) + boff + n * 2048 + k * 1024); } while (0)
#define PG8_MMA(ai, bj, At, Bt) do { __builtin_amdgcn_s_setprio(1); _Pragma("unroll") for (int m = 0; m < 4; ++m) _Pragma("unroll") for (int n = 0; n < 2; ++n) _Pragma("unroll") for (int k = 0; k < 2; ++k) \
        acc[ai][bj][m][n] = __builtin_amdgcn_mfma_f32_16x16x32_bf16(Bt[n][k], At[m][k], acc[ai][bj][m][n], 0, 0, 0); __builtin_amdgcn_s_setprio(0); } while (0)
#define PG8_WAIT_V(n) asm volatile("s_waitcnt vmcnt(" #n ")" ::: "memory")
#define PG8_WAIT_L(n) asm volatile("s_waitcnt lgkmcnt(" #n ")" ::: "memory")
#define PG8_BAR __builtin_amdgcn_s_barrier()
#define PG8_SCHED __builtin_amdgcn_sched_barrier(0)
#define PG8_GATHER_LOAD(vs, uo) do { _Pragma("unroll") for (int _i = 0; _i < 2; ++_i) { int _R, _C; stage_rc(tid * 16 + _i * 8192, _R, _C); _Pragma("unroll") for (int _h = 0; _h < 2; ++_h) \
        (vs)[_h][_i] = (unsigned)tokTab[(uo) * 256 + _h * 128 + _R] * (unsigned)(K * 2) + (unsigned)_C * 2u; } } while (0)
    Unit cur, nxt; int ui = 0;
    if (!S.next(0, cur)) return;
    f32x4 acc[2][2][4][2];
#pragma unroll
    for (int a = 0; a < 2; ++a)
#pragma unroll
        for (int b = 0; b < 2; ++b)
#pragma unroll
            for (int m = 0; m < 4; ++m)
#pragma unroll
                for (int n = 0; n < 2; ++n) acc[a][b][m][n] = (f32x4){0.f, 0.f, 0.f, 0.f};
    bf16x8 At[4][2], B0[2][2], B1[2][2];
    unsigned vC[2][2], v2[2][2];
    if constexpr (GATHER) { PG8_GATHER_LOAD(vC, 0); } else { vC[0][0] = vC[0][1] = vC[1][0] = vC[1][1] = 0u; }
    const char* cA = GATHER ? (const char*)g.A : (const char*)g.A + (size_t)cur.pm * tstep; const char* cB = (const char*)g.Bt + (size_t)cur.pn * tstep;
    PG8_STAGE(PG8_SB(0, 0), cB, voffB); PG8_STAGE(PG8_SB(0, 1), cB + hstep, voffB); PG8_STAGE_A(PG8_SA(0, 0), cA, 0, vC); PG8_STAGE_A(PG8_SA(0, 1), cA, 1, vC);
    if (wr == 1) PG8_BAR;
    PG8_WAIT_V(2); PG8_BAR;
    PG8_STAGE(PG8_SB(1, 0), cB + kstep, voffB); PG8_STAGE_A(PG8_SA(1, 0), cA + kstep, 0, vC); PG8_STAGE(PG8_SB(1, 1), cB + hstep + kstep, voffB);
    PG8_WAIT_V(6); PG8_BAR;
    for (;;) {
        const bool has_next = S.next(ui + 1, nxt);
        const char* nA = GATHER ? (const char*)g.A : (has_next ? (const char*)g.A + (size_t)nxt.pm * tstep : cA); const char* nB = has_next ? (const char*)g.Bt + (size_t)nxt.pn * tstep : cB;
        for (int t = 0; t < nt; t += 2) {
            const bool last = (t == nt - 2);
            const char* a1 = cA + (size_t)(t + 1) * kstep;
            const char* a2 = last ? nA : cA + (size_t)(t + 2) * kstep; const char* b2 = last ? nB : cB + (size_t)(t + 2) * kstep;
            const char* a3 = a2 + kstep; const char* b3 = b2 + kstep;
#pragma unroll
            for (int _h = 0; _h < 2; ++_h) { v2[_h][0] = vC[_h][0]; v2[_h][1] = vC[_h][1]; }
            if constexpr (GATHER) { if (last && has_next) { PG8_GATHER_LOAD(v2, ui + 1); } }
            PG8_LDB(B0, 0, 0); PG8_LDB(B1, 0, 1); PG8_SCHED; PG8_LDA(At, 0, 0); PG8_STAGE_A(PG8_SA(1, 1), a1, 1, vC);
            PG8_WAIT_V(8); PG8_WAIT_L(0); PG8_BAR; PG8_MMA(0, 0, At, B0); PG8_MMA(0, 1, At, B1); PG8_BAR; PG8_SCHED;
            PG8_LDA(At, 0, 1); PG8_STAGE(PG8_SB(0, 0), b2, voffB); PG8_STAGE(PG8_SB(0, 1), b2 + hstep, voffB); PG8_STAGE_A(PG8_SA(0, 0), a2, 0, v2);
            PG8_WAIT_V(8); PG8_WAIT_L(0); PG8_BAR; PG8_MMA(1, 0, At, B0); PG8_MMA(1, 1, At, B1); PG8_BAR; PG8_SCHED;
            PG8_LDB(B0, 1, 0); PG8_LDB(B1, 1, 1); PG8_SCHED; PG8_LDA(At, 1, 0); PG8_STAGE_A(PG8_SA(0, 1), a2, 1, v2);
            PG8_WAIT_V(8); PG8_WAIT_L(0); PG8_BAR; PG8_MMA(0, 0, At, B0); PG8_MMA(0, 1, At, B1); PG8_BAR; PG8_SCHED;
            PG8_LDA(At, 1, 1); PG8_STAGE(PG8_SB(1, 0), b3, voffB); PG8_STAGE(PG8_SB(1, 1), b3 + hstep, voffB); PG8_STAGE_A(PG8_SA(1, 0), a3, 0, v2);
            PG8_WAIT_V(8); PG8_WAIT_L(0); PG8_BAR; PG8_MMA(1, 0, At, B0); PG8_MMA(1, 1, At, B1); PG8_BAR; PG8_SCHED;
        }
        if constexpr (ALIGN_EPI) { if (wr == 0) PG8_BAR; }
        E(acc, cur, wr, wc, fr, fq);
        if (!has_next) break;
#pragma unroll
        for (int a = 0; a < 2; ++a)
#pragma unroll
            for (int b = 0; b < 2; ++b)
#pragma unroll
                for (int m = 0; m < 4; ++m)
#pragma unroll
                    for (int n = 0; n < 2; ++n) acc[a][b][m][n] = (f32x4){0.f, 0.f, 0.f, 0.f};
        cur = nxt; cA = nA; cB = nB; ++ui;
#pragma unroll
        for (int _h = 0; _h < 2; ++_h) { vC[_h][0] = v2[_h][0]; vC[_h][1] = v2[_h][1]; }
        if constexpr (ALIGN_EPI) { if (wr == 1) PG8_BAR; }
    }
    PG8_WAIT_V(0);
    if constexpr (!ALIGN_EPI) { if (wr == 0) PG8_BAR; }
    PG8_BAR;
#undef PG8_SA
#undef PG8_SB
#undef PG8_STAGE
#undef PG8_STAGE_A
#undef PG8_LDA
#undef PG8_LDB
#undef PG8_MMA
#undef PG8_WAIT_V
#undef PG8_WAIT_L
#undef PG8_BAR
#undef PG8_SCHED
#undef PG8_GATHER_LOAD
}

struct EpiProj {
    static constexpr bool PERM = true;
    bf16* O;
    __device__ __forceinline__ void operator()(const f32x4 (&acc)[2][2][4][2], const Unit& u, int wr, int wc, int fr, int fq) const {
        const float sc = (u.pn < 2) ? C2 : 1.f;
#pragma unroll
        for (int ai = 0; ai < 2; ++ai)
#pragma unroll
            for (int m = 0; m < 4; ++m) { bf16* rowp = O + (size_t)(u.pm * BM + ai * HALF + wr * 64 + m * 16 + fr) * INC + u.pn * BM + wc * 32 + 8 * fq;
#pragma unroll
                for (int bj = 0; bj < 2; ++bj) { const f32x4 v0 = acc[ai][bj][m][0] * sc, v1 = acc[ai][bj][m][1] * sc;
                    u32x4 w; w.x = cvt_pk_bf16(v0[0], v0[1]); w.y = cvt_pk_bf16(v0[2], v0[3]); w.z = cvt_pk_bf16(v1[0], v1[1]); w.w = cvt_pk_bf16(v1[2], v1[3]);
                    *(u32x4*)(rowp + bj * HALF) = w; } }
    }
};
struct EpiOut {
    static constexpr bool PERM = false;
    float* O; const float* X; const float* mod;
    __device__ __forceinline__ void operator()(const f32x4 (&acc)[2][2][4][2], const Unit& u, int wr, int wc, int fr, int fq) const {
        const int b = (u.pm * BM) / SEQ; const int col0 = u.pn * BM + wc * 32 + 4 * fq;
        f32x4 gv[2][2];
#pragma unroll
        for (int bj = 0; bj < 2; ++bj)
#pragma unroll
            for (int n = 0; n < 2; ++n) gv[bj][n] = *(const f32x4*)(mod + b * 6144 + 2048 + col0 + bj * HALF + n * 16) + 1.f;
#pragma unroll
        for (int ai = 0; ai < 2; ++ai)
#pragma unroll
            for (int m = 0; m < 4; ++m) { const size_t off = (size_t)(u.pm * BM + ai * HALF + wr * 64 + m * 16 + fr) * DM + col0;
#pragma unroll
                for (int bj = 0; bj < 2; ++bj)
#pragma unroll
                    for (int n = 0; n < 2; ++n) { const f32x4 xv = *(const f32x4*)(X + off + bj * HALF + n * 16);
                        *(f32x4*)(O + off + bj * HALF + n * 16) = xv * ALPHA + gv[bj][n] * acc[ai][bj][m][n]; } }
    }
};
struct EpiGateUp {
    static constexpr bool PERM = true;
    bf16* O;
    __device__ __forceinline__ void operator()(const f32x4 (&acc)[2][2][4][2], const Unit& u, int wr, int wc, int fr, int fq) const {
#pragma unroll
        for (int ai = 0; ai < 2; ++ai)
#pragma unroll
            for (int m = 0; m < 4; ++m) { bf16* rowp = O + (size_t)(u.pm * BM + ai * HALF + wr * 64 + m * 16 + fr) * DEXP + (u.pn & 3) * 128 + wc * 32 + 8 * fq;
                f32x4 h[2];
#pragma unroll
                for (int n = 0; n < 2; ++n)
#pragma unroll
                    for (int c = 0; c < 4; ++c) { const float gt = acc[ai][0][m][n][c], up = acc[ai][1][m][n][c]; h[n][c] = gt * __builtin_amdgcn_rcpf(1.f + __expf(-gt)) * up; }
                u32x4 w; w.x = cvt_pk_bf16(h[0][0], h[0][1]); w.y = cvt_pk_bf16(h[0][2], h[0][3]); w.z = cvt_pk_bf16(h[1][0], h[1][1]); w.w = cvt_pk_bf16(h[1][2], h[1][3]);
                *(u32x4*)rowp = w; }
    }
};
struct EpiDown {
    static constexpr bool PERM = true;
    bf16* O;
    __device__ __forceinline__ void operator()(const f32x4 (&acc)[2][2][4][2], const Unit& u, int wr, int wc, int fr, int fq) const {
#pragma unroll
        for (int ai = 0; ai < 2; ++ai)
#pragma unroll
            for (int m = 0; m < 4; ++m) { bf16* rowp = O + (size_t)(u.pm * BM + ai * HALF + wr * 64 + m * 16 + fr) * DM + (u.pn & 3) * BM + wc * 32 + 8 * fq;
#pragma unroll
                for (int bj = 0; bj < 2; ++bj) { const f32x4 v0 = acc[ai][bj][m][0], v1 = acc[ai][bj][m][1];
                    u32x4 w; w.x = cvt_pk_bf16(v0[0], v0[1]); w.y = cvt_pk_bf16(v0[2], v0[3]); w.z = cvt_pk_bf16(v1[0], v1[1]); w.w = cvt_pk_bf16(v1[2], v1[3]);
                    *(u32x4*)(rowp + bj * HALF) = w; } }
    }
};
struct ExpertOrder {
    const LAS int* toff; int G, v;
    __device__ __forceinline__ bool next(int i, Unit& u) const {
        const int L = i * G + v; const int ntile = toff[32];
        if (L >= ntile * 4) return false;
        const int tile = L >> 2; int e = 0;
        for (int k = 1; k < NEXP; ++k) if (toff[k] <= tile) e = k;
        u.pm = tile; u.pn = e * 4 + (L & 3); return true;
    }
};
}


namespace attn {
using bf16=__hip_bfloat16;
using bf16x8=__attribute__((ext_vector_type(8)))short;
using s16x4=__attribute__((ext_vector_type(4)))short;
using f32x16=__attribute__((ext_vector_type(16)))float;
using u32x4=__attribute__((ext_vector_type(4)))unsigned;
constexpr int NW=8,QBLK=32,QB=QBLK*NW,KVBLK=64,SEQK=2048,PITCH=2304,OPITCH=1024;
__device__ __forceinline__ int crow(int r,int hi){return (r&3)+8*(r>>2)+4*hi;}
#define SBAR() __builtin_amdgcn_sched_barrier(0)

constexpr int NSLOT=3, SLOTB=8192;
constexpr int LDS_K=0, LDS_V=NSLOT*SLOTB, LDS_WS=2*NSLOT*SLOTB, LDS_OST=LDS_WS+NW*64*4, LDS_TB=LDS_OST+NW*4096, LDS_BYTES=LDS_TB+2048;
__device__ __forceinline__ void glds16(const void*gsrc,unsigned lds_dst){unsigned keep;
  asm volatile("s_mov_b32 %0, m0\n\ts_mov_b32 m0, %2\n\ts_nop 0\n\tglobal_load_lds_dwordx4 %1, off\n\ts_mov_b32 m0, %0":"=&s"(keep):"v"(gsrc),"s"(lds_dst):"memory");}
__device__ __forceinline__ float max3f(float a,float b,float c){float r;asm("v_max3_f32 %0, %1, %2, %3":"=v"(r):"v"(a),"v"(b),"v"(c));return r;}
__device__ __forceinline__ float max2f(float a,float b){float r;asm("v_max_f32_e32 %0, %1, %2":"=v"(r):"v"(a),"v"(b));return r;}
__device__ __forceinline__ float fadd_s(float a,float b){float r;asm("v_add_f32_e32 %0, %1, %2":"=v"(r):"v"(a),"v"(b));return r;}
__device__ __forceinline__ float fsub_s(float a,float b){float r;asm("v_sub_f32_e32 %0, %1, %2":"=v"(r):"v"(a),"v"(b));return r;}
typedef float f32x2_t __attribute__((ext_vector_type(2))); typedef __bf16 bf16x2_t __attribute__((ext_vector_type(2)));
__device__ __forceinline__ unsigned cvtpk_s(float lo,float hi){f32x2_t v={lo,hi};bf16x2_t b=__builtin_convertvector(v,bf16x2_t);return __builtin_bit_cast(unsigned,b);}
#define WAIT_BAR(N) asm volatile("s_waitcnt vmcnt(" #N ") lgkmcnt(0)\n\ts_barrier":::"memory")

__device__ __forceinline__ void qkt(f32x16&p0,f32x16&p1,const char*Kslot,const bf16x8*qr,const f32x16&ci0,const f32x16&ci1,int r32,int hi){
  const char*kb=Kslot+hi*1024+r32*16;
  #pragma unroll
  for(int d0=0;d0<4;++d0){
    const bf16x8 b0=*reinterpret_cast<const bf16x8*>(kb+d0*2048);
    const bf16x8 b1=*reinterpret_cast<const bf16x8*>(kb+d0*2048+512);
    if(d0==0){p0=__builtin_amdgcn_mfma_f32_32x32x16_bf16(b0,qr[0],ci0,0,0,0);p1=__builtin_amdgcn_mfma_f32_32x32x16_bf16(b1,qr[0],ci1,0,0,0);}
    else{p0=__builtin_amdgcn_mfma_f32_32x32x16_bf16(b0,qr[d0],p0,0,0,0);p1=__builtin_amdgcn_mfma_f32_32x32x16_bf16(b1,qr[d0],p1,0,0,0);}}
}
typedef __attribute__((address_space(3))) const char* lds_cptr;
typedef short v4i16_t __attribute__((ext_vector_type(4)));
__device__ __forceinline__ void kload8(bf16x8*kf,lds_cptr kp){
  kf[0]=*(const __attribute__((address_space(3))) bf16x8*)(kp);      kf[1]=*(const __attribute__((address_space(3))) bf16x8*)(kp+512);
  kf[2]=*(const __attribute__((address_space(3))) bf16x8*)(kp+2048); kf[3]=*(const __attribute__((address_space(3))) bf16x8*)(kp+2560);
  kf[4]=*(const __attribute__((address_space(3))) bf16x8*)(kp+4096); kf[5]=*(const __attribute__((address_space(3))) bf16x8*)(kp+4608);
  kf[6]=*(const __attribute__((address_space(3))) bf16x8*)(kp+6144); kf[7]=*(const __attribute__((address_space(3))) bf16x8*)(kp+6656);
}
__device__ __forceinline__ void kload2(bf16x8*kf,lds_cptr kp,int j){ kf[2*j]=*(const __attribute__((address_space(3))) bf16x8*)(kp+j*2048); kf[2*j+1]=*(const __attribute__((address_space(3))) bf16x8*)(kp+j*2048+512); }
__device__ __forceinline__ s16x4 vtr(lds_cptr p){ return __builtin_bit_cast(s16x4,__builtin_amdgcn_ds_read_tr16_b64_v4i16((__attribute__((address_space(3))) v4i16_t*)p)); }
__device__ __forceinline__ float rowmax(const f32x16&p0,const f32x16&p1){
  float a=max3f(p0[0],p0[1],p1[0]),b=max3f(p0[2],p0[3],p1[1]);a=max3f(a,p1[2],p1[3]);
  #pragma unroll
  for(int r=4;r<16;r+=4){a=max3f(a,p0[r],p0[r+1]);b=max3f(b,p0[r+2],p0[r+3]);a=max3f(a,p1[r],p1[r+1]);b=max3f(b,p1[r+2],p1[r+3]);}
  const float m=max2f(a,b);
  auto rr=__builtin_amdgcn_permlane32_swap(__float_as_uint(m),__float_as_uint(m),false,false);
  return max2f(__uint_as_float(rr[0]),__uint_as_float(rr[1]));
}
__device__ __forceinline__ void pv(f32x16*o,int vb,bf16x8 pa0,bf16x8 pa1,bf16x8 pa2,bf16x8 pa3){
  #pragma unroll
  for(int d0=0;d0<2;++d0){s16x4 lo[4],hi[4];
    #pragma unroll
    for(int ks=0;ks<4;++ks){
      asm volatile("ds_read_b64_tr_b16 %0,%1 offset:%c2":"=&v"(lo[ks]):"v"(vb),"i"(d0*4096+ks*1024):"memory");
      asm volatile("ds_read_b64_tr_b16 %0,%1 offset:%c2":"=&v"(hi[ks]):"v"(vb),"i"(d0*4096+ks*1024+512):"memory");}
    asm volatile("s_waitcnt lgkmcnt(0)":::"memory");SBAR();
    #define PK(k) (bf16x8){lo[k][0],lo[k][1],lo[k][2],lo[k][3],hi[k][0],hi[k][1],hi[k][2],hi[k][3]}
    o[d0]=__builtin_amdgcn_mfma_f32_32x32x16_bf16(pa0,PK(0),o[d0],0,0,0);
    o[d0]=__builtin_amdgcn_mfma_f32_32x32x16_bf16(pa1,PK(1),o[d0],0,0,0);
    o[d0]=__builtin_amdgcn_mfma_f32_32x32x16_bf16(pa2,PK(2),o[d0],0,0,0);
    o[d0]=__builtin_amdgcn_mfma_f32_32x32x16_bf16(pa3,PK(3),o[d0],0,0,0);
    #undef PK
  }
}

template<int THRL,bool BIAS> __device__ __forceinline__ void attn_run(const bf16*Qb,const bf16*__restrict__ Kh,const bf16*__restrict__ Vh,bf16*Ob,float*Sw,int scol,float lam,float dlt,int qpos0,char*shm){
  int tid_=threadIdx.x; asm volatile("":"+v"(tid_));
  const int tid=tid_,lane=tid&63,r32=lane&31,hi=lane>>5; const int wid=__builtin_amdgcn_readfirstlane(tid>>6);
  const bf16*Qw=Qb+(long)(wid*QBLK)*PITCH;
  const unsigned lds0=(unsigned)(uintptr_t)shm;
  float*wsf=(float*)(shm+LDS_WS)+wid*64;
  const bf16*ksrc=Kh+(long)lane*PITCH+wid*8;
  const bf16*vsrc=Vh+(long)(16*(wid&3)+(lane>>2))*PITCH+(wid>>2)*32+(lane&3)*8;
  const unsigned kdst=lds0+LDS_K+wid*1024, vdst=lds0+LDS_V+wid*1024;
  #define DMA_K(t,slot) glds16(ksrc+(long)(t)*KVBLK*PITCH,(unsigned)__builtin_amdgcn_readfirstlane(kdst+(slot)))
  #define DMA_V(t,slot) glds16(vsrc+(long)(t)*KVBLK*PITCH,(unsigned)__builtin_amdgcn_readfirstlane(vdst+(slot)))
  const int vb0=(int)(lds0+LDS_V)+((lane>>4)&1)*32+(lane&3)*8+(4*hi+((lane&15)>>2))*64;
  const char*Kbase=shm+LDS_K; bf16x8 kf[8];
  const lds_cptr shm3=(lds_cptr)shm; const lds_cptr kp0=shm3+LDS_K+hi*1024+r32*16; const lds_cptr vp0=shm3+LDS_V+((lane>>4)&1)*32+(lane&3)*8+(4*hi+((lane&15)>>2))*64;
  constexpr int NT=SEQK/KVBLK;
  DMA_K(0,0);DMA_V(0,0);DMA_K(1,SLOTB);
  bf16x8 qr[4];
  #pragma unroll
  for(int d0=0;d0<4;++d0)qr[d0]=*reinterpret_cast<const bf16x8*>(&Qw[(long)r32*PITCH+d0*16+hi*8]);
  float mhat=0.f,l_reg=0.f;f32x16 o[2];o[0]=f32x16{};o[1]=f32x16{};f32x16 negm=f32x16{};asm volatile("":"+v"(negm));
  float pc=0.f;
  const int qw0=qpos0+wid*QBLK;
  const int tL=BIAS?((qw0>=154)?((qw0-154)/64+1):0):NT, tR=BIAS?((qw0+122+63)/64):NT;
  const lds_cptr tbp=(lds_cptr)shm+LDS_TB+4*(256-qw0+4*hi-r32);
  #define BIASADD(C0,C1,t) do{ if(BIAS&&(t)>=tL&&(t)<tR){ const lds_cptr tp_=tbp+256*(t); _Pragma("unroll") for(int r=0;r<16;++r){ \
      C0[r]+=*(const __attribute__((address_space(3))) float*)(tp_+4*((r&3)+8*(r>>2))); C1[r]+=*(const __attribute__((address_space(3))) float*)(tp_+4*((r&3)+8*(r>>2)+32)); } } }while(0)
  #define SETPC(t) do{ if(BIAS&&(t)==tR){ pc=dlt; _Pragma("unroll") for(int r=0;r<16;++r)negm[r]=pc-mhat; asm volatile("":"+v"(negm)); } }while(0)
  #define CMASK(P0,P1,t) BIASADD(P0,P1,t)
  bool resc=false;
  #define START(P0,P1) do{ const float rm=rowmax(P0,P1); resc=false; \
    { const float dl=rm; mhat=fadd_s(mhat,dl); \
      _Pragma("unroll") for(int r=0;r<16;++r){P0[r]=fsub_s(P0[r],dl);P1[r]=fsub_s(P1[r],dl);} \
      _Pragma("unroll") for(int r=0;r<16;++r)negm[r]=pc-mhat; asm volatile("":"+v"(negm)); } \
    _Pragma("unroll") for(int r=0;r<16;++r)P0[r]=__builtin_amdgcn_exp2f(P0[r]); }while(0)
  #define RESC() do{ if(resc){ asm volatile("s_waitcnt lgkmcnt(0)":::"memory"); \
      _Pragma("unroll") for(int d_=0;d_<2;++d_) _Pragma("unroll") for(int r=0;r<16;++r)o[d_][r]*=wsf[crow(r,hi)]; } }while(0)
  f32x16 pA0,pA1,pB0,pB1;
  int sl_prev=0,sl_cur=0,sl_next=SLOTB;
  #define ROT() do{sl_prev=sl_cur;sl_cur=sl_next;sl_next=(sl_next==(NSLOT-1)*SLOTB)?0:sl_next+SLOTB;}while(0)
  DMA_K(2,2*SLOTB);
  WAIT_BAR(3);
  SETPC(0);
  qkt(pA0,pA1,Kbase,qr,negm,negm,r32,hi);asm volatile("s_nop 15\n\ts_nop 7":"+v"(pA0),"+v"(pA1));CMASK(pA0,pA1,0);
  START(pA0,pA1);
  _Pragma("unroll") for(int r=0;r<16;++r)pA1[r]=__builtin_amdgcn_exp2f(pA1[r]);
  WAIT_BAR(0);
  DMA_K(3,0);DMA_V(1,SLOTB);
  ROT();
  kload8(kf,kp0+sl_cur);
  WAIT_BAR(2);
  s16x4 vlo[8],vhi[8]; u32x4 pw0,pw1,pw2,pw3;
  #define PKW(P,B) cvtpk_s(P[B],P[B+1])
  #define PAF(k) __builtin_bit_cast(bf16x8,pw##k)
  #define VFR(i) (bf16x8){vlo[i][0],vlo[i][1],vlo[i][2],vlo[i][3],vhi[i][0],vhi[i][1],vhi[i][2],vhi[i][3]}
  #define PIN(x) asm volatile("":"+v"(x))
  #define MX3(a,b,c) __builtin_fmaxf(__builtin_fmaxf((a),(b)),(c))
  #define GAPA(MF,A0,A1,A2,A3,W0,W1,PW) do{ MF; sacc+=A0; sacc+=A1; sacc+=A2; sacc+=A3; PIN(sacc); W0; W1; PIN(PW); SBAR(); }while(0)
  #define EX(v) __builtin_amdgcn_exp2f(v)
  #define GAPB(MF,X,B) do{ MF; X[B]=EX(X[B]); X[B+1]=EX(X[B+1]); X[B+2]=EX(X[B+2]); X[B+3]=EX(X[B+3]); PIN(X); SBAR(); }while(0)
  #define VRD(i) do{ vlo[i]=vtr(vp_+(((i)>>2)*4096+((i)&3)*1024)); vhi[i]=vtr(vp_+(((i)>>2)*4096+((i)&3)*1024+512)); }while(0)
  #define KRD(G,j) do{ if(G){ kload2(kf,kp0+sl_next,j); SBAR(); } }while(0)
  #define STEP(C0,C1,P0,P1,t,GK,GV,GL) do{ SETPC(t); SBAR(); \
    const lds_cptr vp_=vp0+sl_prev; \
    VRD(0); SBAR(); float sacc=(P0[0]+P0[1]); \
    GAPA(C0=__builtin_amdgcn_mfma_f32_32x32x16_bf16(kf[0],qr[0],negm,0,0,0), P0[2],P0[3],P0[4],P0[5],     pw0[0]=PKW(P0,0), pw0[1]=PKW(P0,2), pw0); \
    VRD(4); SBAR(); GAPA(C1=__builtin_amdgcn_mfma_f32_32x32x16_bf16(kf[1],qr[0],negm,0,0,0), P0[6],P0[7],P0[8],P0[9],     pw0[2]=PKW(P0,4), pw0[3]=PKW(P0,6), pw0); \
    VRD(1); SBAR(); GAPA(C0=__builtin_amdgcn_mfma_f32_32x32x16_bf16(kf[2],qr[1],C0,0,0,0),   P0[10],P0[11],P0[12],P0[13], pw1[0]=PKW(P0,8), pw1[1]=PKW(P0,10), pw1); \
    VRD(5); SBAR(); GAPA(C1=__builtin_amdgcn_mfma_f32_32x32x16_bf16(kf[3],qr[1],C1,0,0,0),   P0[14],P0[15],P1[0],P1[1],   pw1[2]=PKW(P0,12),pw1[3]=PKW(P0,14), pw1); \
    VRD(2); SBAR(); GAPA(C0=__builtin_amdgcn_mfma_f32_32x32x16_bf16(kf[4],qr[2],C0,0,0,0),   P1[2],P1[3],P1[4],P1[5],     pw2[0]=PKW(P1,0), pw2[1]=PKW(P1,2), pw2); \
    VRD(6); SBAR(); GAPA(C1=__builtin_amdgcn_mfma_f32_32x32x16_bf16(kf[5],qr[2],C1,0,0,0),   P1[6],P1[7],P1[8],P1[9],     pw2[2]=PKW(P1,4), pw2[3]=PKW(P1,6), pw2); \
    VRD(3); SBAR(); GAPA(C0=__builtin_amdgcn_mfma_f32_32x32x16_bf16(kf[6],qr[3],C0,0,0,0),   P1[10],P1[11],P1[12],P1[13], pw3[0]=PKW(P1,8), pw3[1]=PKW(P1,10), pw3); \
    VRD(7); SBAR(); GAPA(C1=__builtin_amdgcn_mfma_f32_32x32x16_bf16(kf[7],qr[3],C1,0,0,0),   P1[14],P1[15],0.f,0.f,       pw3[2]=PKW(P1,12),pw3[3]=PKW(P1,14), pw3); \
    l_reg+=sacc; \
    if(GK){DMA_K((t)+3,sl_cur);} if(GV){DMA_V((t)+1,sl_next);} \
    CMASK(C0,C1,t); \
    { float a=MX3(C0[0],C0[1],C1[0]),b=MX3(C0[2],C0[3],C1[1]); a=MX3(a,C1[2],C1[3]); \
      _Pragma("unroll") for(int r=4;r<16;r+=4){a=MX3(a,C0[r],C0[r+1]);b=MX3(b,C0[r+2],C0[r+3]);a=MX3(a,C1[r],C1[r+1]);b=MX3(b,C1[r+2],C1[r+3]);} \
      float rm=__builtin_fmaxf(a,b); { auto rr=__builtin_amdgcn_permlane32_swap(__float_as_uint(rm),__float_as_uint(rm),false,false); rm=__builtin_fmaxf(__uint_as_float(rr[0]),__uint_as_float(rr[1])); } \
      resc=false; \
      if(__builtin_expect(__any(rm>(float)THRL),0)){ const float dl=__builtin_fmaxf(rm,0.f); mhat+=dl; \
        _Pragma("unroll") for(int r=0;r<16;++r){C0[r]-=dl;C1[r]-=dl;} \
        _Pragma("unroll") for(int r=0;r<16;++r)negm[r]=pc-mhat; asm volatile("":"+v"(negm)); \
        const float f=__builtin_amdgcn_exp2f(-dl); l_reg*=f; if(hi==0)wsf[r32]=f; resc=true; } } \
    SBAR(); \
    GAPB(o[0]=__builtin_amdgcn_mfma_f32_32x32x16_bf16(PAF(0),VFR(0),o[0],0,0,0), C0,0); \
    GAPB(o[1]=__builtin_amdgcn_mfma_f32_32x32x16_bf16(PAF(0),VFR(4),o[1],0,0,0), C0,4); \
    KRD(GL,0); GAPB(o[0]=__builtin_amdgcn_mfma_f32_32x32x16_bf16(PAF(1),VFR(1),o[0],0,0,0), C0,8); \
    KRD(GL,1); GAPB(o[1]=__builtin_amdgcn_mfma_f32_32x32x16_bf16(PAF(1),VFR(5),o[1],0,0,0), C0,12); \
    KRD(GL,2); GAPB(o[0]=__builtin_amdgcn_mfma_f32_32x32x16_bf16(PAF(2),VFR(2),o[0],0,0,0), C1,0); \
    KRD(GL,3); GAPB(o[1]=__builtin_amdgcn_mfma_f32_32x32x16_bf16(PAF(2),VFR(6),o[1],0,0,0), C1,4); \
    GAPB(o[0]=__builtin_amdgcn_mfma_f32_32x32x16_bf16(PAF(3),VFR(3),o[0],0,0,0), C1,8); \
    GAPB(o[1]=__builtin_amdgcn_mfma_f32_32x32x16_bf16(PAF(3),VFR(7),o[1],0,0,0), C1,12); \
    }while(0)
  int t=1;
  for(;t+5<NT;t+=2){
    STEP(pB0,pB1,pA0,pA1,t,true,true,true);     WAIT_BAR(2); RESC(); ROT();
    STEP(pA0,pA1,pB0,pB1,t+1,true,true,true);   WAIT_BAR(2); RESC(); ROT();
  }
  #define ENDW(tt) do{ if((tt)+3<NT){WAIT_BAR(2);} else if((tt)+2<NT){WAIT_BAR(1);} else {WAIT_BAR(0);} }while(0)
  for(;t+1<NT;t+=2){
    STEP(pB0,pB1,pA0,pA1,t,(t+3<NT),(t+1<NT),(t+1<NT));       ENDW(t);   RESC(); ROT();
    STEP(pA0,pA1,pB0,pB1,t+1,(t+4<NT),(t+2<NT),(t+2<NT));     ENDW(t+1); RESC(); ROT();
  }
  STEP(pB0,pB1,pA0,pA1,NT-1,false,false,false); RESC();
  { float sacc=pB0[0]+pB0[1]; _Pragma("unroll") for(int r=2;r<16;++r)sacc+=pB0[r]; _Pragma("unroll") for(int r=0;r<16;++r)sacc+=pB1[r]; l_reg+=sacc;
    pw0=(u32x4){PKW(pB0,0),PKW(pB0,2),PKW(pB0,4),PKW(pB0,6)};pw1=(u32x4){PKW(pB0,8),PKW(pB0,10),PKW(pB0,12),PKW(pB0,14)};pw2=(u32x4){PKW(pB1,0),PKW(pB1,2),PKW(pB1,4),PKW(pB1,6)};pw3=(u32x4){PKW(pB1,8),PKW(pB1,10),PKW(pB1,12),PKW(pB1,14)};
    SBAR(); pv(o,vb0+sl_cur,PAF(0),PAF(1),PAF(2),PAF(3)); }
  #undef PKW
  #undef PAF
  #undef VFR
  #undef PIN
  #undef MX3
  #undef GAPA
  #undef GAPB
  #undef EX
  #undef VRD
  #undef KRD
  #undef STEP
  #undef BIASADD
  #undef SETPC
  #undef ENDW
  {auto rr=__builtin_amdgcn_permlane32_swap(__float_as_uint(l_reg),__float_as_uint(l_reg),false,false);l_reg=__uint_as_float(rr[0])+__uint_as_float(rr[1]);}
  if(hi==0)wsf[32+r32]=l_reg;asm volatile("s_waitcnt lgkmcnt(0)":::"memory");
  float rli[16];
  #pragma unroll
  for(int r=0;r<16;++r)rli[r]=__builtin_amdgcn_rcpf(wsf[32+crow(r,hi)]);
  if constexpr(!BIAS){ bf16*Ow=Ob+(long)(wid*QBLK)*OPITCH;
    bf16*stg=(bf16*)(shm+LDS_OST)+wid*2048;
    #pragma unroll
    for(int r=0;r<16;++r){const int orow=crow(r,hi);
      #pragma unroll
      for(int d0=0;d0<2;++d0)stg[orow*64+d0*32+r32]=__float2bfloat16(o[d0][r]*rli[r]);}
    asm volatile("s_waitcnt lgkmcnt(0)":::"memory");
    #pragma unroll
    for(int i=0;i<4;++i){const int row=i*8+(lane>>3),ch=lane&7; const u32x4 v=*(const u32x4*)(stg+row*64+ch*8); *(u32x4*)(Ow+(long)row*OPITCH+ch*8)=v;} }
  else { float*Sp=Sw+scol+r32;
    #pragma unroll
    for(int r=0;r<16;++r){const int orow=crow(r,hi);
      #pragma unroll
      for(int d0=0;d0<2;++d0){ float*p=Sp+orow*128+d0*32; const float v=o[d0][r]*rli[r]; if(lam==0.f)*p=v; else *p=*p-lam*v; } } }
  asm volatile("s_waitcnt lgkmcnt(0)\n\ts_barrier":::"memory");
  #undef DMA_K
  #undef DMA_V
  #undef CMASK
  #undef START
  #undef RESC
  #undef ROT
}
#undef SBAR
#undef WAIT_BAR
}

__device__ __forceinline__ void transpose_item(const float* W, int K, int N, bf16* WT, int k0, int n0, int drow0, LAS float* scr, int lane) {
#pragma unroll 8
    for (int i = 0; i < 32; ++i) { const int kk = 2 * i + (lane >> 5); scr[kk * 33 + (lane & 31)] = W[(size_t)(k0 + kk) * N + n0 + (lane & 31)]; }
    asm volatile("s_waitcnt lgkmcnt(0)" ::: "memory");
    const int c = lane & 7;
#pragma unroll
    for (int j = 0; j < 4; ++j) { const int n = (lane >> 3) + 8 * j; const LAS float* s = scr + (8 * c) * 33 + n;
        u32x4 o; o.x = pk2(s[0 * 33], s[1 * 33]); o.y = pk2(s[2 * 33], s[3 * 33]); o.z = pk2(s[4 * 33], s[5 * 33]); o.w = pk2(s[6 * 33], s[7 * 33]);
        *(u32x4*)(WT + (size_t)(drow0 + n) * K + k0 + 8 * c) = o; }
    asm volatile("s_waitcnt lgkmcnt(0)" ::: "memory");
}

__global__ void __launch_bounds__(NTHR, 2) fwd(Args args) {
    extern __shared__ __attribute__((aligned(16))) unsigned char lds_raw[];
    LAS unsigned char* lds = (LAS unsigned char*)lds_raw;
    volatile LAS unsigned* MISC = (volatile LAS unsigned*)(lds + MISC_OFF);
    const int tid = threadIdx.x, lane = tid & 63, wave = __builtin_amdgcn_readfirstlane(tid >> 6);
    const int G = gridDim.x, bid = blockIdx.x;
    unsigned char* ws = args.ws;
    unsigned* ctl = (unsigned*)(ws + WS_CTL);
    for (int u = tid; u < 32; u += NTHR) MISC[u] = 0u;
    __syncthreads();
    XcdBarrier bar; bar.bar = ctl + CW_BAR; bar.x = 0; bar.st = nullptr;
    if (MK_N_LAUNCHES == 1) bar = xcd_barrier_post(ctl + CW_BAR, MISC + 8);
    const int lo = args.ph_lo, hi = args.ph_hi;
#define IN(k) (lo <= (k) && (k) < hi)
#define SEAM(k) do { if (IN(k) && IN((k) + 1)) xcd_barrier(bar); } while (0)

    const float* x = args.in[I_X];
    float* out = args.out;
    float* mod = (float*)(ws + WS_MOD);
    int* tokE = (int*)(ws + WS_TOKE); float* tokW = (float*)(ws + WS_TOKW); int* tokP = (int*)(ws + WS_TOKP);
    int* list = (int*)(ws + WS_LIST);
    bf16* WinT = (bf16*)(ws + WS_WIN); bf16* WoutT = (bf16*)(ws + WS_WOUT); bf16* WguT = (bf16*)(ws + WS_WGU); bf16* WdT = (bf16*)(ws + WS_WD);
    bf16* H = (bf16*)(ws + WS_H); bf16* PROJ = (bf16*)(ws + WS_PROJ); bf16* MIX = (bf16*)(ws + WS_MIX);
    bf16* HID = (bf16*)(ws + WS_HID); bf16* YS = (bf16*)(ws + WS_YS);
    const int gw = bid * NWAVES + wave, NGW = G * NWAVES;
    const int vcu = (G % 8 == 0) ? (bid % 8) * (G / 8) + bid / 8 : bid;

    if (IN(0)) {
        const float* c = args.in[I_C]; const float* w_ada = args.in[I_WADA]; const float* b_ada = args.in[I_BADA];
        if (bid < 96) {
            LAS float* sl = (LAS float*)lds;
            LAS float* part = (LAS float*)(lds + 32768);
            for (int i = tid; i < NB * DM; i += NTHR) { const float v = c[i]; sl[i] = v / (1.f + __expf(-v)); }
            __syncthreads();
            for (int item = bid; item < 96; item += G) {
                const int col = item * 64 + lane;
                float acc[NB];
#pragma unroll
                for (int b = 0; b < NB; ++b) acc[b] = 0.f;
                for (int k = wave * 128; k < wave * 128 + 128; ++k) {
                    const float wv = w_ada[(size_t)k * 6144 + col];
#pragma unroll
                    for (int b = 0; b < NB; ++b) acc[b] += sl[b * DM + k] * wv;
                }
#pragma unroll
                for (int b = 0; b < NB; ++b) part[(wave * NB + b) * 64 + lane] = acc[b];
                __syncthreads();
                { const int b = tid >> 6; float s = 0.f;
#pragma unroll
                  for (int w = 0; w < NWAVES; ++w) s += part[(w * NB + b) * 64 + lane];
                  mod[b * 6144 + col] = s + b_ada[col]; }
                __syncthreads();
            }
        }
        __syncthreads();
        LAS float* scr = (LAS float*)(lds + wave * 16384);
        constexpr int I_IN = 1152, I_OUT = 512, I_EXP = 768, NITEMS = I_IN + I_OUT + NEXP * I_EXP;
        for (int it = gw; it < NITEMS; it += NGW) {
            int r = it;
            if (r < I_IN) { const int kb = r / 72, nb = r % 72; transpose_item(args.in[I_WIN], DM, INC, WinT, 64 * kb, 32 * nb, 32 * nb, scr, lane); continue; } r -= I_IN;
            if (r < I_OUT) { const int kb = r / 32, nb = r % 32; transpose_item(args.in[I_WOUT], DM, DM, WoutT, 64 * kb, 32 * nb, 32 * nb, scr, lane); continue; } r -= I_OUT;
            const int e = r / I_EXP; r -= e * I_EXP;
            if (r < 256) { const int kb = r / 16, nb = r % 16, j0 = 32 * nb;
                transpose_item(args.in[I_WGATE] + (size_t)e * DM * DEXP, DM, DEXP, WguT + (size_t)e * 1024 * 1024, 64 * kb, j0, (j0 >> 7) * 256 + (j0 & 127), scr, lane); continue; } r -= 256;
            if (r < 256) { const int kb = r / 16, nb = r % 16, j0 = 32 * nb;
                transpose_item(args.in[I_WUP] + (size_t)e * DM * DEXP, DM, DEXP, WguT + (size_t)e * 1024 * 1024, 64 * kb, j0, (j0 >> 7) * 256 + 128 + (j0 & 127), scr, lane); continue; } r -= 256;
            { const int kb = r / 32, nb = r % 32;
                transpose_item(args.in[I_WDOWN] + (size_t)e * DEXP * DM, DEXP, DM, WdT + (size_t)e * 1024 * 512, 64 * kb, 32 * nb, 32 * nb, scr, lane); }
        }
    }
    SEAM(0);

    if (IN(1)) {
        int lane_o = tid & 63; asm volatile("" : "+v"(lane_o)); const int lane = lane_o;
        for (int m = gw; m < T; m += NGW) {
            const int b = m / SEQ;
            const f32x4* xr = (const f32x4*)(x + (size_t)m * DM) + lane;
            const f32x4* sh = (const f32x4*)(mod + b * 6144) + lane; const f32x4* sc = (const f32x4*)(mod + b * 6144 + 1024) + lane;
            f32x4 v[4]; float s = 0.f;
#pragma unroll
            for (int j = 0; j < 4; ++j) { v[j] = xr[64 * j]; s += (v[j].x + v[j].y) + (v[j].z + v[j].w); }
            const float mean = wave_sum(s) * (1.f / DM); float s2 = 0.f;
#pragma unroll
            for (int j = 0; j < 4; ++j) { v[j] = v[j] - mean; s2 += (v[j].x * v[j].x + v[j].y * v[j].y) + (v[j].z * v[j].z + v[j].w * v[j].w); }
            const float rstd = 1.f / sqrtf(wave_sum(s2) * (1.f / DM) + LN_EPS);
            unsigned long long* o8 = (unsigned long long*)(H + (size_t)m * DM) + lane;
#pragma unroll
            for (int j = 0; j < 4; ++j) { const f32x4 a = sc[64 * j], d = sh[64 * j]; const f32x4 h = v[j] * rstd * (a + 1.f) + d;
                o8[64 * j] = (unsigned long long)pk2(h.x, h.y) | ((unsigned long long)pk2(h.z, h.w) << 32); }
        }
    }
    SEAM(1);

    if (IN(2)) {
        pg8::Gemm g{H, WinT, DM}; pg8::StaticOrder S; S.init(T, INC, G, bid);
        pg8::EpiProj E{PROJ};
        pg8::gemm_phase<pg8::EpiProj, pg8::StaticOrder, true, false>(lds, g, S, E, nullptr);
    }
    SEAM(2);

    if (IN(3)) {
        int lane_o = tid & 63; asm volatile("" : "+v"(lane_o)); const int lane = lane_o;
        const float* qg = args.in[I_QNG]; const float* kg = args.in[I_KNG];
        const int hl = lane >> 5, p = lane & 31;
        for (int m = gw; m < T; m += NGW) {
            const int s = m % SEQ; const float pos = (p < 16) ? (float)(s / 64) : (float)(s % 64);
            const float freq = powf(10000.f, -(float)(2 * (p & 15)) / 32.f);
            const float ang = pos * freq; const float cs = cosf(ang), sn = sinf(ang);
#pragma unroll
            for (int it = 0; it < 5; ++it) {
                const int hd = it * 2 + hl;
                const bool isq = hd < 8;
                bf16* ptr = PROJ + (size_t)m * INC + (isq ? C_GQ + hd * 64 : C_GK + (hd - 8) * 64) + 2 * p;
                const unsigned w = *(const unsigned*)ptr;
                const float x1 = bf2f((unsigned short)(w & 0xffffu)), x2 = bf2f((unsigned short)(w >> 16));
                const float ss = half_sum(x1 * x1 + x2 * x2);
                const float r = 1.f / sqrtf(ss * (1.f / 64.f) + RMS_EPS);
                const float* g = isq ? qg : kg;
                const float y1 = x1 * r * g[2 * p], y2 = x2 * r * g[2 * p + 1];
                float o1 = y1 * cs - y2 * sn, o2 = y1 * sn + y2 * cs;
                if (isq) { o1 *= C2; o2 *= C2; }
                *(unsigned*)ptr = pk2(o1, o2);
            }
        }
    }
    SEAM(3);

    if (IN(4)) {
        char* shm = (char*)lds_raw;
        const float* relb = args.in[I_RELB];
        float lam;
        { float d1 = 0.f, d2 = 0.f;
          for (int i = 0; i < 64; ++i) { d1 += args.in[I_LQ1][i] * args.in[I_LK1][i]; d2 += args.in[I_LQ2][i] * args.in[I_LK2][i]; }
          lam = expf(d1) - expf(d2) + LAMBDA_INIT; }
        float* Sw = out + ((size_t)bid * NWAVES + wave) * 4096;
        const attn::bf16* PJ = (const attn::bf16*)PROJ;
        for (int id = vcu; id < 256; id += G) {
            const int b = id >> 5, h = (id >> 3) & 3, qb = id & 7;
            __syncthreads();
            { int t2 = (int)threadIdx.x; asm volatile("" : "+v"(t2));
              LAS float* tb = (LAS float*)(lds + attn::LDS_TB); const int rel = t2 - 256; const int n = rel < 0 ? -rel : rel;
              int bk; if (n < 8) bk = n; else { const int l2 = 31 - __clz(n * n); bk = 8 + l2 - 6; if (bk > 15) bk = 15; }
              if (rel > 0) bk += 16;
              tb[t2] = (relb[bk * 4 + h] - relb[15 * 4 + h]) * LOG2E; }
            __syncthreads();
            const float dlt = (relb[31 * 4 + h] - relb[15 * 4 + h]) * LOG2E;
            const size_t row0 = (size_t)b * SEQ + qb * 256;
#pragma unroll 1
            for (int ps = 0; ps < 4; ++ps) { const int cm = ps >> 1, vh = ps & 1;
                attn::attn_run<8, true>(PJ + row0 * INC + C_DQ + h * 128 + cm * 64, PJ + (size_t)b * SEQ * INC + C_DK + h * 128 + cm * 64, PJ + (size_t)b * SEQ * INC + C_DV + h * 128 + vh * 64,
                                        nullptr, Sw, vh * 64, cm ? lam : 0.f, dlt, qb * 256, shm); }
            asm volatile("s_waitcnt vmcnt(0)" ::: "memory");
            { int ln = (int)__builtin_amdgcn_mbcnt_hi(~0u, __builtin_amdgcn_mbcnt_lo(~0u, 0u)); asm volatile("" : "+v"(ln));
              const float* sg = args.in[I_SUBLN]; const float g0 = sg[2 * ln], g1 = sg[2 * ln + 1];
              const float* Sr = Sw + 2 * ln; bf16* Mr = MIX + (row0 + wave * 32) * DM + h * 128 + 2 * ln;
#pragma unroll 4
              for (int r = 0; r < 32; ++r) { const float d0 = Sr[r * 128], d1 = Sr[r * 128 + 1];
                const float ss = wave_sum(d0 * d0 + d1 * d1); const float rr = (1.f - LAMBDA_INIT) / sqrtf(ss * (1.f / 128.f) + RMS_EPS);
                *(unsigned*)(Mr + (size_t)r * DM) = pk2(d0 * rr * g0, d1 * rr * g1); } }
        }
        for (int id2 = vcu; id2 < 256; id2 += G)
#pragma unroll 1
            for (int i = 0; i < 2; ++i) { const int id = 2 * id2 + i; const int b = id >> 6, hd = (id >> 3) & 7, qb = id & 7;
                const size_t row0 = (size_t)b * SEQ + qb * 256;
                attn::attn_run<8, false>(PJ + row0 * INC + C_GQ + hd * 64, PJ + (size_t)b * SEQ * INC + C_GK + (hd >> 2) * 64, PJ + (size_t)b * SEQ * INC + C_GV + (hd >> 2) * 64,
                                         (attn::bf16*)MIX + row0 * DM + 512 + hd * 64, nullptr, 0, 0.f, 0.f, 0, shm); }
    }
    SEAM(4);

    if (IN(5)) {
        pg8::Gemm g{MIX, WoutT, DM}; pg8::StaticOrder S; S.init(T, DM, G, bid);
        pg8::EpiOut E{out, x, mod};
        pg8::gemm_phase<pg8::EpiOut, pg8::StaticOrder, false, false>(lds, g, S, E, nullptr);
    }
    SEAM(5);

    if (IN(6)) {
        int lane_o = tid & 63; asm volatile("" : "+v"(lane_o)); const int lane = lane_o;
        const float* g1v = args.in[I_LN1G]; const float* b1v = args.in[I_LN1B];
        const float* wrg = args.in[I_WRG]; const float* brg = args.in[I_BRG]; const float* wre = args.in[I_WRE]; const float* bre = args.in[I_BRE];
        for (int m = gw; m < T; m += NGW) {
            const int b = m / SEQ;
            f32x4* yr = (f32x4*)(out + (size_t)m * DM) + lane;
            f32x4 v[4]; float s = 0.f;
#pragma unroll
            for (int j = 0; j < 4; ++j) { v[j] = yr[64 * j]; s += (v[j].x + v[j].y) + (v[j].z + v[j].w); }
            float mean = wave_sum(s) * (1.f / DM); float s2 = 0.f;
#pragma unroll
            for (int j = 0; j < 4; ++j) { v[j] = v[j] - mean; s2 += (v[j].x * v[j].x + v[j].y * v[j].y) + (v[j].z * v[j].z + v[j].w * v[j].w); }
            float rstd = 1.f / sqrtf(wave_sum(s2) * (1.f / DM) + LN_EPS);
            s = 0.f;
#pragma unroll
            for (int j = 0; j < 4; ++j) { const f32x4 gg = ((const f32x4*)g1v)[64 * j + lane], bb = ((const f32x4*)b1v)[64 * j + lane];
                v[j] = v[j] * rstd * gg + bb; yr[64 * j] = v[j]; s += (v[j].x + v[j].y) + (v[j].z + v[j].w); }
            mean = wave_sum(s) * (1.f / DM); s2 = 0.f;
#pragma unroll
            for (int j = 0; j < 4; ++j) { v[j] = v[j] - mean; s2 += (v[j].x * v[j].x + v[j].y * v[j].y) + (v[j].z * v[j].z + v[j].w * v[j].w); }
            rstd = 1.f / sqrtf(wave_sum(s2) * (1.f / DM) + LN_EPS);
            const f32x4* sh = (const f32x4*)(mod + b * 6144 + 3072) + lane; const f32x4* sc = (const f32x4*)(mod + b * 6144 + 4096) + lane;
            unsigned long long* o8 = (unsigned long long*)(H + (size_t)m * DM) + lane;
#pragma unroll
            for (int j = 0; j < 4; ++j) { v[j] = v[j] * rstd * (sc[64 * j] + 1.f) + sh[64 * j];
                o8[64 * j] = (unsigned long long)pk2(v[j].x, v[j].y) | ((unsigned long long)pk2(v[j].z, v[j].w) << 32); }
            float lg[36];
#pragma unroll
            for (int o = 0; o < 36; ++o) lg[o] = 0.f;
#pragma unroll
            for (int j = 0; j < 4; ++j)
#pragma unroll
                for (int cc = 0; cc < 4; ++cc) { const int col = 4 * lane + 256 * j + cc; const float hv = v[j][cc];
                    const f32x4 wg = *(const f32x4*)(wrg + col * 4);
#pragma unroll
                    for (int o = 0; o < 4; ++o) lg[o] += hv * wg[o];
#pragma unroll
                    for (int g = 0; g < 4; ++g) { const f32x4 w0 = *(const f32x4*)(wre + ((size_t)g * DM + col) * 8), w1 = *(const f32x4*)(wre + ((size_t)g * DM + col) * 8 + 4);
#pragma unroll
                        for (int o = 0; o < 4; ++o) { lg[4 + g * 8 + o] += hv * w0[o]; lg[4 + g * 8 + 4 + o] += hv * w1[o]; } } }
#pragma unroll
            for (int o = 0; o < 36; ++o) lg[o] = wave_sum(lg[o]);
            if (lane == 0) {
                volatile LAS float* wl = (volatile LAS float*)(lds + 131072 + 8192 + wave * 256);
                float gl[4]; int gs = 0;
#pragma unroll
                for (int o = 0; o < 4; ++o) gl[o] = lg[o] + brg[o];
                float gmax = gl[0];
#pragma unroll
                for (int o = 1; o < 4; ++o) if (gl[o] > gmax) { gmax = gl[o]; gs = o; }
                float den = 0.f;
#pragma unroll
                for (int o = 0; o < 4; ++o) den += expf(gl[o] - gmax);
                const float pg = 1.f / den;
                float el[8];
#pragma unroll
                for (int o = 0; o < 32; ++o) wl[o] = lg[4 + o];
#pragma unroll
                for (int o = 0; o < 8; ++o) el[o] = wl[gs * 8 + o] + bre[gs * 8 + o];
                int i1 = 0; float v1 = el[0];
#pragma unroll
                for (int o = 1; o < 8; ++o) if (el[o] > v1) { v1 = el[o]; i1 = o; }
                int i2 = -1; float v2 = -3.0e38f;
#pragma unroll
                for (int o = 0; o < 8; ++o) if (o != i1 && (i2 < 0 || el[o] > v2)) { v2 = el[o]; i2 = o; }
                const float ex = expf(v2 - v1);
                const float wa = pg / (1.f + ex), wb = pg * ex / (1.f + ex);
                const int e1 = gs * 8 + i1, e2 = gs * 8 + i2;
                const int p1 = (int)atomicAdd(ctl + CW_CNT + 64 * e1, 1u); const int p2 = (int)atomicAdd(ctl + CW_CNT + 64 * e2, 1u);
                list[(size_t)e1 * T + p1] = m; list[(size_t)e2 * T + p2] = m;
                tokE[2 * m] = e1; tokE[2 * m + 1] = e2; tokW[2 * m] = wa; tokW[2 * m + 1] = wb; tokP[2 * m] = p1; tokP[2 * m + 1] = p2;
            }
        }
    }
    SEAM(6);

    LAS int* toff = (LAS int*)(lds + 131072 + 4096);
    if (hi > 7) {
        __syncthreads();
        if (tid == 0) { int acc = 0; for (int e = 0; e < NEXP; ++e) { const int cnt = (int)__hip_atomic_load(ctl + CW_CNT + 64 * e, __ATOMIC_RELAXED, __HIP_MEMORY_SCOPE_AGENT);
            toff[e] = acc; toff[64 + e] = cnt; acc += (cnt + 255) >> 8; } toff[32] = acc; }
        __syncthreads();
    }

    if (IN(7)) {
        LAS int* tokTab = (LAS int*)(lds + 131072 + 12288);
        pg8::ExpertOrder S{toff, G, vcu};
        { pg8::Unit u;
          for (int i = 0; i < 4 && S.next(i, u); ++i) { const int e = u.pn >> 2; const int cnt = toff[64 + e]; const int r0 = (u.pm - toff[e]) * 256;
              for (int r = tid; r < 256; r += NTHR) tokTab[i * 256 + r] = (r0 + r < cnt) ? list[(size_t)e * T + r0 + r] : 0; } }
        __syncthreads();
        pg8::Gemm g{H, WguT, DM};
        pg8::EpiGateUp E{HID};
        pg8::gemm_phase<pg8::EpiGateUp, pg8::ExpertOrder, true, true>(lds, g, S, E, tokTab);
    }
    SEAM(7);

    if (IN(8)) {
        pg8::ExpertOrder S{toff, G, vcu};
        pg8::Gemm g{HID, WdT, DEXP};
        pg8::EpiDown E{YS};
        pg8::gemm_phase<pg8::EpiDown, pg8::ExpertOrder, true, false>(lds, g, S, E, nullptr);
    }
    SEAM(8);

    if (IN(9)) {
        int lane_o = tid & 63; asm volatile("" : "+v"(lane_o)); const int lane = lane_o;
        const float* g2v = args.in[I_LN2G]; const float* b2v = args.in[I_LN2B];
        for (int m = gw; m < T; m += NGW) {
            const int b = m / SEQ;
            const int e1 = tokE[2 * m], e2 = tokE[2 * m + 1]; const float wa = tokW[2 * m], wb = tokW[2 * m + 1];
            const size_t sa = (size_t)toff[e1] * 256 + tokP[2 * m], sb = (size_t)toff[e2] * 256 + tokP[2 * m + 1];
            f32x4* xr = (f32x4*)(out + (size_t)m * DM) + lane;
            const u32x2* ya = (const u32x2*)(YS + sa * DM) + lane; const u32x2* yb = (const u32x2*)(YS + sb * DM) + lane;
            const f32x4* gg2 = (const f32x4*)(mod + b * 6144 + 5120) + lane;
            f32x4 v[4]; float s = 0.f;
#pragma unroll
            for (int j = 0; j < 4; ++j) { const f32x4 xv = xr[64 * j]; const u32x2 a = ya[64 * j], bq = yb[64 * j]; const f32x4 g2 = gg2[64 * j] + 1.f;
                f32x4 fa, fb;
                fa.x = bf2f((unsigned short)(a.x & 0xffffu)); fa.y = bf2f((unsigned short)(a.x >> 16)); fa.z = bf2f((unsigned short)(a.y & 0xffffu)); fa.w = bf2f((unsigned short)(a.y >> 16));
                fb.x = bf2f((unsigned short)(bq.x & 0xffffu)); fb.y = bf2f((unsigned short)(bq.x >> 16)); fb.z = bf2f((unsigned short)(bq.y & 0xffffu)); fb.w = bf2f((unsigned short)(bq.y >> 16));
                v[j] = xv * ALPHA + g2 * (fa * wa + fb * wb); s += (v[j].x + v[j].y) + (v[j].z + v[j].w); }
            const float mean = wave_sum(s) * (1.f / DM); float s2 = 0.f;
#pragma unroll
            for (int j = 0; j < 4; ++j) { v[j] = v[j] - mean; s2 += (v[j].x * v[j].x + v[j].y * v[j].y) + (v[j].z * v[j].z + v[j].w * v[j].w); }
            const float rstd = 1.f / sqrtf(wave_sum(s2) * (1.f / DM) + LN_EPS);
#pragma unroll
            for (int j = 0; j < 4; ++j) { const f32x4 gg = ((const f32x4*)g2v)[64 * j + lane], bb = ((const f32x4*)b2v)[64 * j + lane]; xr[64 * j] = v[j] * rstd * gg + bb; }
        }
    }
#undef IN
#undef SEAM
}

extern "C" void kernel_launch(void* const* d_in, const int* in_sizes, int n_in, void* d_out, int out_size, void* d_ws, size_t ws_size, hipStream_t stream) {
    static int grid = 0;
    if (grid == 0) {
        if (n_in != 25 || out_size != T * DM || ws_size < WS_END) { fprintf(stderr, "kernel_launch: unexpected shapes (n_in %d out %d ws %zu)\n", n_in, out_size, ws_size); grid = -1; return; }
        int dev = 0, cus = 0, per_cu = 0;
        if (hipGetDevice(&dev) != hipSuccess || hipDeviceGetAttribute(&cus, hipDeviceAttributeMultiprocessorCount, dev) != hipSuccess) { grid = -1; return; }
        if (hipFuncSetAttribute((const void*)fwd, hipFuncAttributeMaxDynamicSharedMemorySize, LDS_BYTES) != hipSuccess) { fprintf(stderr, "kernel_launch: hipFuncSetAttribute failed\n"); grid = -1; return; }
        if (hipOccupancyMaxActiveBlocksPerMultiprocessor(&per_cu, (const void*)fwd, NTHR, LDS_BYTES) != hipSuccess || per_cu < 1) { fprintf(stderr, "kernel_launch: occupancy query says %d\n", per_cu); }
        (void)hipGetLastError();
        grid = cus;
    }
    if (grid < 0) return;
    (void)hipMemsetAsync((char*)d_ws + WS_CTL, 0, CTL_ZERO_BYTES, stream);
    Args a{};
    for (int i = 0; i < 25; ++i) a.in[i] = (const float*)d_in[i];
    a.out = (float*)d_out; a.ws = (unsigned char*)d_ws; a.pad = 0;
    if (MK_N_LAUNCHES == 1) {
        a.ph_lo = 0; a.ph_hi = NPH; a.li = 0;
        hipLaunchKernelGGL(fwd, dim3(grid), dim3(NTHR), LDS_BYTES, stream, a);
    } else {
        for (int p = 0; p < NPH; ++p) { a.ph_lo = p; a.ph_hi = p + 1; a.li = p; hipLaunchKernelGGL(fwd, dim3(grid), dim3(NTHR), LDS_BYTES, stream, a); }
    }
}
```

```cpp
#include <hip/hip_runtime.h>
#include <cstdio>
#include <cstdint>
#include <hip/hip_bf16.h>

#ifndef PROBE_REP
#define PROBE_REP -1
#endif
#ifndef MK_N_LAUNCHES
#define MK_N_LAUNCHES 1
#endif

#define GAS __attribute__((address_space(1)))
#define LAS __attribute__((address_space(3)))
typedef unsigned short bf16;
typedef short bf16x8 __attribute__((ext_vector_type(8)));
typedef float f32x4 __attribute__((ext_vector_type(4)));
typedef unsigned u32x4 __attribute__((ext_vector_type(4)));
typedef unsigned u32x2 __attribute__((ext_vector_type(2)));

constexpr int NB = 8, SEQ = 2048, DM = 1024, T = NB * SEQ;
constexpr int INC = 2304;
constexpr int C_DQ = 0, C_DK = 512, C_DV = 1024, C_GQ = 1536, C_GK = 2048, C_GV = 2176;
constexpr int NEXP = 32, DEXP = 512;
constexpr float LN_EPS = 1e-5f, RMS_EPS = 1e-6f;
constexpr float ALPHA = 1.189207115002721f;
constexpr float LAMBDA_INIT = 0.2f;
constexpr float LOG2E = 1.4426950408889634f;
constexpr float C2 = 0.125f * LOG2E;
constexpr int NWAVES = 8, NTHR = 512;
constexpr int NPH = 10;

constexpr size_t MiB = 1u << 20;
constexpr size_t WS_CTL = 0, CTL_ZERO_BYTES = 1 * MiB;
constexpr size_t WS_MOD = 1 * MiB;
constexpr size_t WS_TOKE = 2 * MiB;
constexpr size_t WS_TOKW = 2 * MiB + 256 * 1024;
constexpr size_t WS_TOKP = 2 * MiB + 512 * 1024;
constexpr size_t WS_LIST = 4 * MiB;
constexpr size_t WS_WIN = 8 * MiB;
constexpr size_t WS_WOUT = 14 * MiB;
constexpr size_t WS_WGU = 16 * MiB;
constexpr size_t WS_WD = 80 * MiB;
constexpr size_t WS_H = 112 * MiB;
constexpr size_t WS_PROJ = 144 * MiB;
constexpr size_t WS_MIX = 216 * MiB;
constexpr size_t WS_HID = 216 * MiB;
constexpr size_t WS_YS = 112 * MiB;
constexpr size_t WS_END = 256 * MiB;
constexpr int MAXSLOT = 40960;
constexpr int CW_BAR = 4096;
constexpr int CW_CNT = 16384;

__device__ __forceinline__ unsigned f2bf(float f) { unsigned u = __builtin_bit_cast(unsigned, f); return (u + 0x7fffu + ((u >> 16) & 1u)) >> 16; }
__device__ __forceinline__ unsigned pk2(float lo, float hi) { return f2bf(lo) | (f2bf(hi) << 16); }
__device__ __forceinline__ float bf2f(unsigned short u) { return __builtin_bit_cast(float, (unsigned)u << 16); }
template <int CTRL> __device__ __forceinline__ float dpp_f(float v) { return __builtin_bit_cast(float, __builtin_amdgcn_update_dpp(0, __builtin_bit_cast(int, v), CTRL, 0xF, 0xF, true)); }
__device__ __forceinline__ float row16_sum(float v) {
    v += dpp_f<0xB1>(v);
    v += dpp_f<0x4E>(v);
    v += dpp_f<0x141>(v);
    v += dpp_f<0x140>(v);
    return v;
}
__device__ __forceinline__ float half_sum(float v) {
    v = row16_sum(v);
    auto rr = __builtin_amdgcn_permlane16_swap(__float_as_uint(v), __float_as_uint(v), false, false);
    return __uint_as_float(rr[0]) + __uint_as_float(rr[1]);
}
__device__ __forceinline__ float wave_sum(float v) {
    v = half_sum(v);
    auto rr = __builtin_amdgcn_permlane32_swap(__float_as_uint(v), __float_as_uint(v), false, false);
    return __uint_as_float(rr[0]) + __uint_as_float(rr[1]);
}

#define XB_TMO      128
#define XB_XCNT(j)  (256  + 64 * (j))
#define XB_XSUB(j)  (1280 + 64 * (j))
#define XB_XGEN(j)  (2304 + 64 * (j))
#define XB_TOP      3328
#define XB_TOPGEN   3392
#define XCD_BAR_WORDS 3456
#define XB_SPIN_CAP (1u << 18)
__device__ __forceinline__ unsigned xb_ld(unsigned* p)              { return __hip_atomic_load(p, __ATOMIC_RELAXED, __HIP_MEMORY_SCOPE_AGENT); }
__device__ __forceinline__ unsigned xb_add(unsigned* p, unsigned v) { return __hip_atomic_fetch_add(p, v, __ATOMIC_RELAXED, __HIP_MEMORY_SCOPE_AGENT); }
__device__ __forceinline__ unsigned xb_xcc_id() { return (unsigned)__builtin_amdgcn_s_getreg((3 << 11) | 20) & 0xFu; }
#define XB_SPIN(cond, bar) do { unsigned _sp = 0; while (cond) { __builtin_amdgcn_s_sleep(1); \
    if ((++_sp & 255u) == 0u) { if (xb_ld(&(bar)[XB_TMO])) break; if (_sp > XB_SPIN_CAP) { atomicAdd(&(bar)[XB_TMO], 1u); break; } } } } while (0)
struct XcdBarrier { unsigned* bar; unsigned x; volatile LAS unsigned* st; };
__device__ __forceinline__ XcdBarrier xcd_barrier_post(unsigned* bar, volatile LAS unsigned* st) {
    XcdBarrier b; b.bar = bar; b.x = xb_xcc_id(); b.st = st;
    if (threadIdx.x == 0) (void)xb_add(&bar[XB_XCNT(b.x)], 1u);
    return b;
}
__device__ __forceinline__ void xcd_barrier_complete(unsigned* bar, unsigned x, unsigned& nloc, unsigned& nx) {
    const unsigned G = gridDim.x * gridDim.y * gridDim.z;
    unsigned sum, cnt, mine, sp = 0u;
    for (;;) {
        sum = 0u; cnt = 0u; mine = 0u;
#pragma unroll
        for (unsigned j = 0; j < 16; ++j) { const unsigned c = xb_ld(&bar[XB_XCNT(j)]); sum += c; cnt += (c > 0u) ? 1u : 0u; mine = (j == x) ? c : mine; }
        if (sum == G) break;
        __builtin_amdgcn_s_sleep(1);
        if ((++sp & 255u) == 0u) { if (xb_ld(&bar[XB_TMO])) break; if (sp > XB_SPIN_CAP) { atomicAdd(&bar[XB_TMO], 1u); break; } }
    }
    nloc = mine > 0u ? mine : 1u; nx = cnt > 0u ? cnt : 1u;
}
__device__ __forceinline__ void xcd_barrier(const XcdBarrier& b) {
    asm volatile("s_waitcnt vmcnt(0)" ::: "memory");
    __syncthreads();
    if (threadIdx.x == 0) {
        unsigned* bar = b.bar;
        __builtin_amdgcn_s_waitcnt(0);
        unsigned nloc = b.st[0], nx = b.st[1];
        if (nloc == 0u) { xcd_barrier_complete(bar, b.x, nloc, nx); b.st[0] = nloc; b.st[1] = nx; }
        const unsigned old = xb_add(&bar[XB_XSUB(b.x)], 1u);
        const unsigned gen = old / nloc;
        if (old + 1u == (gen + 1u) * nloc) {
            __builtin_amdgcn_fence(__ATOMIC_RELEASE, "agent");
            asm volatile("s_waitcnt vmcnt(0)" ::: "memory");
            const unsigned og = xb_add(&bar[XB_TOP], 1u);
            const unsigned tg = og / nx;
            if (og + 1u == (tg + 1u) * nx) xb_add(&bar[XB_TOPGEN], 1u);
            else XB_SPIN(xb_ld(&bar[XB_TOPGEN]) == tg, bar);
            __builtin_amdgcn_fence(__ATOMIC_ACQUIRE, "agent");
            xb_add(&bar[XB_XGEN(b.x)], 1u);
            asm volatile("s_waitcnt vmcnt(0)" ::: "memory");
        } else {
            XB_SPIN(xb_ld(&bar[XB_XGEN(b.x)]) == gen, bar);
            __builtin_amdgcn_fence(__ATOMIC_ACQUIRE, "agent");
            asm volatile("s_waitcnt vmcnt(0)" ::: "memory");
        }
    }
    __syncthreads();
}

struct Args {
    const float* in[25]; float* out; unsigned char* ws; int ph_lo, ph_hi, li, pad;
};
enum { I_X = 0, I_C, I_WADA, I_BADA, I_WIN, I_LQ1, I_LK1, I_LQ2, I_LK2, I_SUBLN, I_QNG, I_KNG, I_RELB, I_WOUT, I_LN1G, I_LN1B,
       I_WRG, I_BRG, I_WRE, I_BRE, I_WGATE, I_WUP, I_WDOWN, I_LN2G, I_LN2B };

constexpr int LDS_BYTES = 148480;
constexpr int AUX_OFF = 131072;
constexpr int MISC_OFF = 147456;

__device__ __forceinline__ void wave_gemm64(const bf16* (&arow)[4], const bf16* (&brow)[4], int K, f32x4 (&acc)[4][4], int lane) {
    const int kq = (lane >> 4) * 8;
#pragma unroll
    for (int i = 0; i < 4; ++i)
#pragma unroll
        for (int j = 0; j < 4; ++j) acc[i][j] = (f32x4){0.f, 0.f, 0.f, 0.f};
    for (int k0 = 0; k0 < K; k0 += 32) {
        bf16x8 a[4], b[4];
#pragma unroll
        for (int i = 0; i < 4; ++i) a[i] = *(const bf16x8*)(arow[i] + k0 + kq);
#pragma unroll
        for (int j = 0; j < 4; ++j) b[j] = *(const bf16x8*)(brow[j] + k0 + kq);
#pragma unroll
        for (int i = 0; i < 4; ++i)
#pragma unroll
            for (int j = 0; j < 4; ++j) acc[i][j] = __builtin_amdgcn_mfma_f32_16x16x32_bf16(a[i], b[j], acc[i][j], 0, 0, 0);
    }
}


namespace pg8 {
constexpr int BM = 256, BK = 64, HALF = 128, HTB = HALF * BK * 2, STAGE_BYTES = 8 * HTB, NXCD = 8, WGM = 8;
__host__ __device__ __forceinline__ int lds_byte(int r, int c) { const int st = (r >> 4) * 2 + (c >> 5), rr = r & 15, cc = c & 31, ob = rr * 64 + cc * 2; return st * 1024 + (ob ^ (((ob >> 9) & 1) << 5)); }
__host__ __device__ __forceinline__ void stage_rc(int b, int& R, int& C) { const int st = b / 1024, sb = b % 1024, swz = sb ^ (((sb >> 9) & 1) << 5); R = (st >> 1) * 16 + swz / 64; C = (st & 1) * 32 + (swz % 64) / 2; }
__host__ __device__ __forceinline__ int perm32(int rho) { const int n = rho >> 4, i = rho & 15; return 8 * (i >> 2) + 4 * n + (i & 3); }
struct Unit { int pm, pn; };
struct Gemm { const bf16* A; const bf16* Bt; int K; };
struct StaticOrder {
    int nM, nN, nwg, G, c;
    __device__ void init(int M, int N, int G_, int c_) { nM = M / BM; nN = N / BM; nwg = nM * nN; G = G_; c = c_; }
    __device__ bool next(int i, Unit& u) const {
        const long L = (long)i * G + c; if (L >= nwg) return false;
        int wgid = (int)L; { const int q = nwg / NXCD, r = nwg % NXCD, xcd = wgid % NXCD, off = wgid / NXCD; wgid = (xcd < r ? xcd * (q + 1) : r * (q + 1) + (xcd - r) * q) + off; }
        const int nig = WGM * nN, gid = wgid / nig, fm = gid * WGM, gsz = (nM - fm) < WGM ? (nM - fm) : WGM;
        u.pm = fm + ((wgid % nig) % gsz); u.pn = (wgid % nig) / gsz; return true;
    }
};
__device__ __forceinline__ unsigned cvt_pk_bf16(float lo, float hi) { unsigned r; asm volatile("v_cvt_pk_bf16_f32 %0, %1, %2" : "=v"(r) : "v"(lo), "v"(hi)); return r; }

template <class Epi, class Sched, bool ALIGN_EPI, bool GATHER>
__device__ __forceinline__ void gemm_phase(LAS unsigned char* lds, const Gemm g, const Sched& S, const Epi& E, const LAS int* tokTab) {
    const int tid = threadIdx.x, wid = __builtin_amdgcn_readfirstlane(tid >> 6), lane = tid & 63, wr = wid >> 2, wc = wid & 3, fr = lane & 15, fq = lane >> 4;
    const int K = g.K, nt = K / BK;
    unsigned voffA[2], voffB[2];
#pragma unroll
    for (int i = 0; i < 2; ++i) { int R, C; stage_rc(tid * 16 + i * 8192, R, C); const int Rb = Epi::PERM ? ((R & ~31) + perm32(R & 31)) : R;
        voffA[i] = (unsigned)(R * K + C) * 2u; voffB[i] = (unsigned)(Rb * K + C) * 2u; }
    const size_t kstep = (size_t)(BK * 2);
    const size_t hstep = (size_t)HALF * K * 2;
    const size_t tstep = 2 * hstep;
    const unsigned ldsw = (unsigned)wid * 1024u;
    const int aoff = lds_byte(wr * 64 + fr, fq * 8), boff = lds_byte(wc * 32 + fr, fq * 8);
#define PG8_SA(b, h) (((b) * 2 + (h)) * HTB)
#define PG8_SB(b, h) ((4 + (b) * 2 + (h)) * HTB)
#define PG8_STAGE(bufoff, gbase, voff) do { _Pragma("unroll") for (int _i = 0; _i < 2; ++_i) \
        __builtin_amdgcn_global_load_lds((const unsigned*)((const char*)(gbase) + (voff)[_i]), (LAS unsigned*)(lds + (bufoff) + ldsw + _i * 8192), 16, 0, 0); } while (0)
#define PG8_STAGE_A(bufoff, kptr, h, vs) do { if constexpr (GATHER) { PG8_STAGE(bufoff, kptr, (vs)[h]); } else { PG8_STAGE(bufoff, (kptr) + (h) * hstep, voffA); } } while (0)
#define PG8_LDA(dst, b, h) do { _Pragma("unroll") for (int m = 0; m < 4; ++m) _Pragma("unroll") for (int k = 0; k < 2; ++k) dst[m][k] = *(const LAS bf16x8*)(lds + PG8_SA(b, h) + aoff + m * 2048 + k * 1024); } while (0)
#define PG8_LDB(dst, b, h) do { _Pragma("unroll") for (int n = 0; n < 2; ++n) _Pragma("unroll") for (int k = 0; k < 2; ++k) dst[n][k] = *(const LAS bf16x8*)(lds + PG8_SB(b, h) + boff + n * 2048 + k * 1024); } while (0)
#define PG8_MMA(ai, bj, At, Bt) do { __builtin_amdgcn_s_setprio(1); _Pragma("unroll") for (int m = 0; m < 4; ++m) _Pragma("unroll") for (int n = 0; n < 2; ++n) _Pragma("unroll") for (int k = 0; k < 2; ++k) \
        acc[ai][bj][m][n] = __builtin_amdgcn_mfma_f32_16x16x32_bf16(Bt[n][k], At[m][k], acc[ai][bj][m][n], 0, 0, 0); __builtin_amdgcn_s_setprio(0); } while (0)
#define PG8_WAIT_V(n) asm volatile("s_waitcnt vmcnt(" #n ")" ::: "memory")
#define PG8_WAIT_L(n) asm volatile("s_waitcnt lgkmcnt(" #n ")" ::: "memory")
#define PG8_BAR __builtin_amdgcn_s_barrier()
#define PG8_SCHED __builtin_amdgcn_sched_barrier(0)
#define PG8_GATHER_LOAD(vs, uo) do { _Pragma("unroll") for (int _i = 0; _i < 2; ++_i) { int _R, _C; stage_rc(tid * 16 + _i * 8192, _R, _C); _Pragma("unroll") for (int _h = 0; _h < 2; ++_h) \
        (vs)[_h][_i] = (unsigned)tokTab[(uo) * 256 + _h * 128 + _R] * (unsigned)(K * 2) + (unsigned)_C * 2u; } } while (0)
    Unit cur, nxt; int ui = 0;
    if (!S.next(0, cur)) return;
    f32x4 acc[2][2][4][2];
#pragma unroll
    for (int a = 0; a < 2; ++a)
#pragma unroll
        for (int b = 0; b < 2; ++b)
#pragma unroll
            for (int m = 0; m < 4; ++m)
#pragma unroll
                for (int n = 0; n < 2; ++n) acc[a][b][m][n] = (f32x4){0.f, 0.f, 0.f, 0.f};
    bf16x8 At[4][2], B0[2][2], B1[2][2];
    unsigned vC[2][2], v2[2][2];
    if constexpr (GATHER) { PG8_GATHER_LOAD(vC, 0); } else { vC[0][0] = vC[0][1] = vC[1][0] = vC[1][1] = 0u; }
    const char* cA = GATHER ? (const char*)g.A : (const char*)g.A + (size_t)cur.pm * tstep; const char* cB = (const char*)g.Bt + (size_t)cur.pn * tstep;
    PG8_STAGE(PG8_SB(0, 0), cB, voffB); PG8_STAGE(PG8_SB(0, 1), cB + hstep, voffB); PG8_STAGE_A(PG8_SA(0, 0), cA, 0, vC); PG8_STAGE_A(PG8_SA(0, 1), cA, 1, vC);
    if (wr == 1) PG8_BAR;
    PG8_WAIT_V(2); PG8_BAR;
    PG8_STAGE(PG8_SB(1, 0), cB + kstep, voffB); PG8_STAGE_A(PG8_SA(1, 0), cA + kstep, 0, vC); PG8_STAGE(PG8_SB(1, 1), cB + hstep + kstep, voffB);
    PG8_WAIT_V(6); PG8_BAR;
    for (;;) {
        const bool has_next = S.next(ui + 1, nxt);
        const char* nA = GATHER ? (const char*)g.A : (has_next ? (const char*)g.A + (size_t)nxt.pm * tstep : cA); const char* nB = has_next ? (const char*)g.Bt + (size_t)nxt.pn * tstep : cB;
        for (int t = 0; t < nt; t += 2) {
            const bool last = (t == nt - 2);
            const char* a1 = cA + (size_t)(t + 1) * kstep;
            const char* a2 = last ? nA : cA + (size_t)(t + 2) * kstep; const char* b2 = last ? nB : cB + (size_t)(t + 2) * kstep;
            const char* a3 = a2 + kstep; const char* b3 = b2 + kstep;
#pragma unroll
            for (int _h = 0; _h < 2; ++_h) { v2[_h][0] = vC[_h][0]; v2[_h][1] = vC[_h][1]; }
            if constexpr (GATHER) { if (last && has_next) { PG8_GATHER_LOAD(v2, ui + 1); } }
            PG8_LDB(B0, 0, 0); PG8_LDB(B1, 0, 1); PG8_SCHED; PG8_LDA(At, 0, 0); PG8_STAGE_A(PG8_SA(1, 1), a1, 1, vC);
            PG8_WAIT_V(8); PG8_WAIT_L(0); PG8_BAR; PG8_MMA(0, 0, At, B0); PG8_MMA(0, 1, At, B1); PG8_BAR; PG8_SCHED;
            PG8_LDA(At, 0, 1); PG8_STAGE(PG8_SB(0, 0), b2, voffB); PG8_STAGE(PG8_SB(0, 1), b2 + hstep, voffB); PG8_STAGE_A(PG8_SA(0, 0), a2, 0, v2);
            PG8_WAIT_V(8); PG8_WAIT_L(0); PG8_BAR; PG8_MMA(1, 0, At, B0); PG8_MMA(1, 1, At, B1); PG8_BAR; PG8_SCHED;
            PG8_LDB(B0, 1, 0); PG8_LDB(B1, 1, 1); PG8_SCHED; PG8_LDA(At, 1, 0); PG8_STAGE_A(PG8_SA(0, 1), a2, 1, v2);
            PG8_WAIT_V(8); PG8_WAIT_L(0); PG8_BAR; PG8_MMA(0, 0, At, B0); PG8_MMA(0, 1, At, B1); PG8_BAR; PG8_SCHED;
            PG8_LDA(At, 1, 1); PG8_STAGE(PG8_SB(1, 0), b3, voffB); PG8_STAGE(PG8_SB(1, 1), b3 + hstep, voffB); PG8_STAGE_A(PG8_SA(1, 0), a3, 0, v2);
            PG8_WAIT_V(8); PG8_WAIT_L(0); PG8_BAR; PG8_MMA(1, 0, At, B0); PG8_MMA(1, 1, At, B1); PG8_BAR; PG8_SCHED;
        }
        if constexpr (ALIGN_EPI) { if (wr == 0) PG8_BAR; }
        E(acc, cur, wr, wc, fr, fq);
        if (!has_next) break;
#pragma unroll
        for (int a = 0; a < 2; ++a)
#pragma unroll
            for (int b = 0; b < 2; ++b)
#pragma unroll
                for (int m = 0; m < 4; ++m)
#pragma unroll
                    for (int n = 0; n < 2; ++n) acc[a][b][m][n] = (f32x4){0.f, 0.f, 0.f, 0.f};
        cur = nxt; cA = nA; cB = nB; ++ui;
#pragma unroll
        for (int _h = 0; _h < 2; ++_h) { vC[_h][0] = v2[_h][0]; vC[_h][1] = v2[_h][1]; }
        if constexpr (ALIGN_EPI) { if (wr == 1) PG8_BAR; }
    }
    PG8_WAIT_V(0);
    if constexpr (!ALIGN_EPI) { if (wr == 0) PG8_BAR; }
    PG8_BAR;
#undef PG8_SA
#undef PG8_SB
#undef PG8_STAGE
#undef PG8_STAGE_A
#undef PG8_LDA
#undef PG8_LDB
#undef PG8_MMA
#undef PG8_WAIT_V
#undef PG8_WAIT_L
#undef PG8_BAR
#undef PG8_SCHED
#undef PG8_GATHER_LOAD
}

struct EpiProj {
    static constexpr bool PERM = true;
    bf16* O;
    __device__ __forceinline__ void operator()(const f32x4 (&acc)[2][2][4][2], const Unit& u, int wr, int wc, int fr, int fq) const {
        const float sc = (u.pn < 2) ? C2 : 1.f;
#pragma unroll
        for (int ai = 0; ai < 2; ++ai)
#pragma unroll
            for (int m = 0; m < 4; ++m) { bf16* rowp = O + (size_t)(u.pm * BM + ai * HALF + wr * 64 + m * 16 + fr) * INC + u.pn * BM + wc * 32 + 8 * fq;
#pragma unroll
                for (int bj = 0; bj < 2; ++bj) { const f32x4 v0 = acc[ai][bj][m][0] * sc, v1 = acc[ai][bj][m][1] * sc;
                    u32x4 w; w.x = cvt_pk_bf16(v0[0], v0[1]); w.y = cvt_pk_bf16(v0[2], v0[3]); w.z = cvt_pk_bf16(v1[0], v1[1]); w.w = cvt_pk_bf16(v1[2], v1[3]);
                    *(u32x4*)(rowp + bj * HALF) = w; } }
    }
};
struct EpiOut {
    static constexpr bool PERM = false;
    float* O; const float* X; const float* mod;
    __device__ __forceinline__ void operator()(const f32x4 (&acc)[2][2][4][2], const Unit& u, int wr, int wc, int fr, int fq) const {
        const int b = (u.pm * BM) / SEQ; const int col0 = u.pn * BM + wc * 32 + 4 * fq;
        f32x4 gv[2][2];
#pragma unroll
        for (int bj = 0; bj < 2; ++bj)
#pragma unroll
            for (int n = 0; n < 2; ++n) gv[bj][n] = *(const f32x4*)(mod + b * 6144 + 2048 + col0 + bj * HALF + n * 16) + 1.f;
#pragma unroll
        for (int ai = 0; ai < 2; ++ai)
#pragma unroll
            for (int m = 0; m < 4; ++m) { const size_t off = (size_t)(u.pm * BM + ai * HALF + wr * 64 + m * 16 + fr) * DM + col0;
#pragma unroll
                for (int bj = 0; bj < 2; ++bj)
#pragma unroll
                    for (int n = 0; n < 2; ++n) { const f32x4 xv = *(const f32x4*)(X + off + bj * HALF + n * 16);
                        *(f32x4*)(O + off + bj * HALF + n * 16) = xv * ALPHA + gv[bj][n] * acc[ai][bj][m][n]; } }
    }
};
struct EpiGateUp {
    static constexpr bool PERM = true;
    bf16* O;
    __device__ __forceinline__ void operator()(const f32x4 (&acc)[2][2][4][2], const Unit& u, int wr, int wc, int fr, int fq) const {
#pragma unroll
        for (int ai = 0; ai < 2; ++ai)
#pragma unroll
            for (int m = 0; m < 4; ++m) { bf16* rowp = O + (size_t)(u.pm * BM + ai * HALF + wr * 64 + m * 16 + fr) * DEXP + (u.pn & 3) * 128 + wc * 32 + 8 * fq;
                f32x4 h[2];
#pragma unroll
                for (int n = 0; n < 2; ++n)
#pragma unroll
                    for (int c = 0; c < 4; ++c) { const float gt = acc[ai][0][m][n][c], up = acc[ai][1][m][n][c]; h[n][c] = gt * __builtin_amdgcn_rcpf(1.f + __expf(-gt)) * up; }
                u32x4 w; w.x = cvt_pk_bf16(h[0][0], h[0][1]); w.y = cvt_pk_bf16(h[0][2], h[0][3]); w.z = cvt_pk_bf16(h[1][0], h[1][1]); w.w = cvt_pk_bf16(h[1][2], h[1][3]);
                *(u32x4*)rowp = w; }
    }
};
struct EpiDown {
    static constexpr bool PERM = true;
    bf16* O;
    __device__ __forceinline__ void operator()(const f32x4 (&acc)[2][2][4][2], const Unit& u, int wr, int wc, int fr, int fq) const {
#pragma unroll
        for (int ai = 0; ai < 2; ++ai)
#pragma unroll
            for (int m = 0; m < 4; ++m) { bf16* rowp = O + (size_t)(u.pm * BM + ai * HALF + wr * 64 + m * 16 + fr) * DM + (u.pn & 3) * BM + wc * 32 + 8 * fq;
#pragma unroll
                for (int bj = 0; bj < 2; ++bj) { const f32x4 v0 = acc[ai][bj][m][0], v1 = acc[ai][bj][m][1];
                    u32x4 w; w.x = cvt_pk_bf16(v0[0], v0[1]); w.y = cvt_pk_bf16(v0[2], v0[3]); w.z = cvt_pk_bf16(v1[0], v1[1]); w.w = cvt_pk_bf16(v1[2], v1[3]);
                    *(u32x4*)(rowp + bj * HALF) = w; } }
    }
};
struct ExpertOrder {
    const LAS int* toff; int G, v;
    __device__ __forceinline__ bool next(int i, Unit& u) const {
        const int L = i * G + v; const int ntile = toff[32];
        if (L >= ntile * 4) return false;
        const int tile = L >> 2; int e = 0;
        for (int k = 1; k < NEXP; ++k) if (toff[k] <= tile) e = k;
        u.pm = tile; u.pn = e * 4 + (L & 3); return true;
    }
};
}


namespace attn {
using bf16=__hip_bfloat16;
using bf16x8=__attribute__((ext_vector_type(8)))short;
using s16x4=__attribute__((ext_vector_type(4)))short;
using f32x16=__attribute__((ext_vector_type(16)))float;
using u32x4=__attribute__((ext_vector_type(4)))unsigned;
constexpr int NW=8,QBLK=32,QB=QBLK*NW,KVBLK=64,SEQK=2048,PITCH=2304,OPITCH=1024;
__device__ __forceinline__ int crow(int r,int hi){return (r&3)+8*(r>>2)+4*hi;}
#define SBAR() __builtin_amdgcn_sched_barrier(0)

constexpr int NSLOT=3, SLOTB=8192;
constexpr int LDS_K=0, LDS_V=NSLOT*SLOTB, LDS_WS=2*NSLOT*SLOTB, LDS_OST=LDS_WS+NW*64*4, LDS_TB=LDS_OST+NW*4096, LDS_BYTES=LDS_TB+2048;
__device__ __forceinline__ void glds16(const void*gsrc,unsigned lds_dst){unsigned keep;
  asm volatile("s_mov_b32 %0, m0\n\ts_mov_b32 m0, %2\n\ts_nop 0\n\tglobal_load_lds_dwordx4 %1, off\n\ts_mov_b32 m0, %0":"=&s"(keep):"v"(gsrc),"s"(lds_dst):"memory");}
__device__ __forceinline__ float max3f(float a,float b,float c){float r;asm("v_max3_f32 %0, %1, %2, %3":"=v"(r):"v"(a),"v"(b),"v"(c));return r;}
__device__ __forceinline__ float max2f(float a,float b){float r;asm("v_max_f32_e32 %0, %1, %2":"=v"(r):"v"(a),"v"(b));return r;}
__device__ __forceinline__ float fadd_s(float a,float b){float r;asm("v_add_f32_e32 %0, %1, %2":"=v"(r):"v"(a),"v"(b));return r;}
__device__ __forceinline__ float fsub_s(float a,float b){float r;asm("v_sub_f32_e32 %0, %1, %2":"=v"(r):"v"(a),"v"(b));return r;}
typedef float f32x2_t __attribute__((ext_vector_type(2))); typedef __bf16 bf16x2_t __attribute__((ext_vector_type(2)));
__device__ __forceinline__ unsigned cvtpk_s(float lo,float hi){f32x2_t v={lo,hi};bf16x2_t b=__builtin_convertvector(v,bf16x2_t);return __builtin_bit_cast(unsigned,b);}
#define WAIT_BAR(N) asm volatile("s_waitcnt vmcnt(" #N ") lgkmcnt(0)\n\ts_barrier":::"memory")

__device__ __forceinline__ void qkt(f32x16&p0,f32x16&p1,const char*Kslot,const bf16x8*qr,const f32x16&ci0,const f32x16&ci1,int r32,int hi){
  const char*kb=Kslot+hi*1024+r32*16;
  #pragma unroll
  for(int d0=0;d0<4;++d0){
    const bf16x8 b0=*reinterpret_cast<const bf16x8*>(kb+d0*2048);
    const bf16x8 b1=*reinterpret_cast<const bf16x8*>(kb+d0*2048+512);
    if(d0==0){p0=__builtin_amdgcn_mfma_f32_32x32x16_bf16(b0,qr[0],ci0,0,0,0);p1=__builtin_amdgcn_mfma_f32_32x32x16_bf16(b1,qr[0],ci1,0,0,0);}
    else{p0=__builtin_amdgcn_mfma_f32_32x32x16_bf16(b0,qr[d0],p0,0,0,0);p1=__builtin_amdgcn_mfma_f32_32x32x16_bf16(b1,qr[d0],p1,0,0,0);}}
}
typedef __attribute__((address_space(3))) const char* lds_cptr;
typedef short v4i16_t __attribute__((ext_vector_type(4)));
__device__ __forceinline__ void kload8(bf16x8*kf,lds_cptr kp){
  kf[0]=*(const __attribute__((address_space(3))) bf16x8*)(kp);      kf[1]=*(const __attribute__((address_space(3))) bf16x8*)(kp+512);
  kf[2]=*(const __attribute__((address_space(3))) bf16x8*)(kp+2048); kf[3]=*(const __attribute__((address_space(3))) bf16x8*)(kp+2560);
  kf[4]=*(const __attribute__((address_space(3))) bf16x8*)(kp+4096); kf[5]=*(const __attribute__((address_space(3))) bf16x8*)(kp+4608);
  kf[6]=*(const __attribute__((address_space(3))) bf16x8*)(kp+6144); kf[7]=*(const __attribute__((address_space(3))) bf16x8*)(kp+6656);
}
__device__ __forceinline__ void kload2(bf16x8*kf,lds_cptr kp,int j){ kf[2*j]=*(const __attribute__((address_space(3))) bf16x8*)(kp+j*2048); kf[2*j+1]=*(const __attribute__((address_space(3))) bf16x8*)(kp+j*2048+512); }
__device__ __forceinline__ s16x4 vtr(lds_cptr p){ return __builtin_bit_cast(s16x4,__builtin_amdgcn_ds_read_tr16_b64_v4i16((__attribute__((address_space(3))) v4i16_t*)p)); }
__device__ __forceinline__ float rowmax(const f32x16&p0,const f32x16&p1){
  float a=max3f(p0[0],p0[1],p1[0]),b=max3f(p0[2],p0[3],p1[1]);a=max3f(a,p1[2],p1[3]);
  #pragma unroll
  for(int r=4;r<16;r+=4){a=max3f(a,p0[r],p0[r+1]);b=max3f(b,p0[r+2],p0[r+3]);a=max3f(a,p1[r],p1[r+1]);b=max3f(b,p1[r+2],p1[r+3]);}
  const float m=max2f(a,b);
  auto rr=__builtin_amdgcn_permlane32_swap(__float_as_uint(m),__float_as_uint(m),false,false);
  return max2f(__uint_as_float(rr[0]),__uint_as_float(rr[1]));
}
__device__ __forceinline__ void pv(f32x16*o,int vb,bf16x8 pa0,bf16x8 pa1,bf16x8 pa2,bf16x8 pa3){
  #pragma unroll
  for(int d0=0;d0<2;++d0){s16x4 lo[4],hi[4];
    #pragma unroll
    for(int ks=0;ks<4;++ks){
      asm volatile("ds_read_b64_tr_b16 %0,%1 offset:%c2":"=&v"(lo[ks]):"v"(vb),"i"(d0*4096+ks*1024):"memory");
      asm volatile("ds_read_b64_tr_b16 %0,%1 offset:%c2":"=&v"(hi[ks]):"v"(vb),"i"(d0*4096+ks*1024+512):"memory");}
    asm volatile("s_waitcnt lgkmcnt(0)":::"memory");SBAR();
    #define PK(k) (bf16x8){lo[k][0],lo[k][1],lo[k][2],lo[k][3],hi[k][0],hi[k][1],hi[k][2],hi[k][3]}
    o[d0]=__builtin_amdgcn_mfma_f32_32x32x16_bf16(pa0,PK(0),o[d0],0,0,0);
    o[d0]=__builtin_amdgcn_mfma_f32_32x32x16_bf16(pa1,PK(1),o[d0],0,0,0);
    o[d0]=__builtin_amdgcn_mfma_f32_32x32x16_bf16(pa2,PK(2),o[d0],0,0,0);
    o[d0]=__builtin_amdgcn_mfma_f32_32x32x16_bf16(pa3,PK(3),o[d0],0,0,0);
    #undef PK
  }
}

template<int THRL,bool BIAS> __device__ __forceinline__ void attn_run(const bf16*Qb,const bf16*__restrict__ Kh,const bf16*__restrict__ Vh,bf16*Ob,float*Sw,int scol,float lam,float dlt,int qpos0,char*shm){
  int tid_=threadIdx.x; asm volatile("":"+v"(tid_));
  const int tid=tid_,lane=tid&63,r32=lane&31,hi=lane>>5; const int wid=__builtin_amdgcn_readfirstlane(tid>>6);
  const bf16*Qw=Qb+(long)(wid*QBLK)*PITCH;
  const unsigned lds0=(unsigned)(uintptr_t)shm;
  float*wsf=(float*)(shm+LDS_WS)+wid*64;
  const bf16*ksrc=Kh+(long)lane*PITCH+wid*8;
  const bf16*vsrc=Vh+(long)(16*(wid&3)+(lane>>2))*PITCH+(wid>>2)*32+(lane&3)*8;
  const unsigned kdst=lds0+LDS_K+wid*1024, vdst=lds0+LDS_V+wid*1024;
  #define DMA_K(t,slot) glds16(ksrc+(long)(t)*KVBLK*PITCH,(unsigned)__builtin_amdgcn_readfirstlane(kdst+(slot)))
  #define DMA_V(t,slot) glds16(vsrc+(long)(t)*KVBLK*PITCH,(unsigned)__builtin_amdgcn_readfirstlane(vdst+(slot)))
  const int vb0=(int)(lds0+LDS_V)+((lane>>4)&1)*32+(lane&3)*8+(4*hi+((lane&15)>>2))*64;
  const char*Kbase=shm+LDS_K; bf16x8 kf[8];
  const lds_cptr shm3=(lds_cptr)shm; const lds_cptr kp0=shm3+LDS_K+hi*1024+r32*16; const lds_cptr vp0=shm3+LDS_V+((lane>>4)&1)*32+(lane&3)*8+(4*hi+((lane&15)>>2))*64;
  constexpr int NT=SEQK/KVBLK;
  DMA_K(0,0);DMA_V(0,0);DMA_K(1,SLOTB);
  bf16x8 qr[4];
  #pragma unroll
  for(int d0=0;d0<4;++d0)qr[d0]=*reinterpret_cast<const bf16x8*>(&Qw[(long)r32*PITCH+d0*16+hi*8]);
  float mhat=0.f,l_reg=0.f;f32x16 o[2];o[0]=f32x16{};o[1]=f32x16{};f32x16 negm=f32x16{};asm volatile("":"+v"(negm));
  float pc=0.f;
  const int qw0=qpos0+wid*QBLK;
  const int tL=BIAS?((qw0>=154)?((qw0-154)/64+1):0):NT, tR=BIAS?((qw0+122+63)/64):NT;
  const lds_cptr tbp=(lds_cptr)shm+LDS_TB+4*(256-qw0+4*hi-r32);
  #define BIASADD(C0,C1,t) do{ if(BIAS&&(t)>=tL&&(t)<tR){ const lds_cptr tp_=tbp+256*(t); _Pragma("unroll") for(int r=0;r<16;++r){ \
      C0[r]+=*(const __attribute__((address_space(3))) float*)(tp_+4*((r&3)+8*(r>>2))); C1[r]+=*(const __attribute__((address_space(3))) float*)(tp_+4*((r&3)+8*(r>>2)+32)); } } }while(0)
  #define SETPC(t) do{ if(BIAS&&(t)==tR){ pc=dlt; _Pragma("unroll") for(int r=0;r<16;++r)negm[r]=pc-mhat; asm volatile("":"+v"(negm)); } }while(0)
  #define CMASK(P0,P1,t) BIASADD(P0,P1,t)
  bool resc=false;
  #define START(P0,P1) do{ const float rm=rowmax(P0,P1); resc=false; \
    { const float dl=rm; mhat=fadd_s(mhat,dl); \
      _Pragma("unroll") for(int r=0;r<16;++r){P0[r]=fsub_s(P0[r],dl);P1[r]=fsub_s(P1[r],dl);} \
      _Pragma("unroll") for(int r=0;r<16;++r)negm[r]=pc-mhat; asm volatile("":"+v"(negm)); } \
    _Pragma("unroll") for(int r=0;r<16;++r)P0[r]=__builtin_amdgcn_exp2f(P0[r]); }while(0)
  #define RESC() do{ if(resc){ asm volatile("s_waitcnt lgkmcnt(0)":::"memory"); \
      _Pragma("unroll") for(int d_=0;d_<2;++d_) _Pragma("unroll") for(int r=0;r<16;++r)o[d_][r]*=wsf[crow(r,hi)]; } }while(0)
  f32x16 pA0,pA1,pB0,pB1;
  int sl_prev=0,sl_cur=0,sl_next=SLOTB;
  #define ROT() do{sl_prev=sl_cur;sl_cur=sl_next;sl_next=(sl_next==(NSLOT-1)*SLOTB)?0:sl_next+SLOTB;}while(0)
  DMA_K(2,2*SLOTB);
  WAIT_BAR(3);
  SETPC(0);
  qkt(pA0,pA1,Kbase,qr,negm,negm,r32,hi);asm volatile("s_nop 15\n\ts_nop 7":"+v"(pA0),"+v"(pA1));CMASK(pA0,pA1,0);
  START(pA0,pA1);
  _Pragma("unroll") for(int r=0;r<16;++r)pA1[r]=__builtin_amdgcn_exp2f(pA1[r]);
  WAIT_BAR(0);
  DMA_K(3,0);DMA_V(1,SLOTB);
  ROT();
  kload8(kf,kp0+sl_cur);
  WAIT_BAR(2);
  s16x4 vlo[8],vhi[8]; u32x4 pw0,pw1,pw2,pw3;
  #define PKW(P,B) cvtpk_s(P[B],P[B+1])
  #define PAF(k) __builtin_bit_cast(bf16x8,pw##k)
  #define VFR(i) (bf16x8){vlo[i][0],vlo[i][1],vlo[i][2],vlo[i][3],vhi[i][0],vhi[i][1],vhi[i][2],vhi[i][3]}
  #define PIN(x) asm volatile("":"+v"(x))
  #define MX3(a,b,c) __builtin_fmaxf(__builtin_fmaxf((a),(b)),(c))
  #define GAPA(MF,A0,A1,A2,A3,W0,W1,PW) do{ MF; sacc+=A0; sacc+=A1; sacc+=A2; sacc+=A3; PIN(sacc); W0; W1; PIN(PW); SBAR(); }while(0)
  #define EX(v) __builtin_amdgcn_exp2f(v)
  #define GAPB(MF,X,B) do{ MF; X[B]=EX(X[B]); X[B+1]=EX(X[B+1]); X[B+2]=EX(X[B+2]); X[B+3]=EX(X[B+3]); PIN(X); SBAR(); }while(0)
  #define VRD(i) do{ vlo[i]=vtr(vp_+(((i)>>2)*4096+((i)&3)*1024)); vhi[i]=vtr(vp_+(((i)>>2)*4096+((i)&3)*1024+512)); }while(0)
  #define KRD(G,j) do{ if(G){ kload2(kf,kp0+sl_next,j); SBAR(); } }while(0)
  #define STEP(C0,C1,P0,P1,t,GK,GV,GL) do{ SETPC(t); SBAR(); \
    const lds_cptr vp_=vp0+sl_prev; \
    VRD(0); SBAR(); float sacc=(P0[0]+P0[1]); \
    GAPA(C0=__builtin_amdgcn_mfma_f32_32x32x16_bf16(kf[0],qr[0],negm,0,0,0), P0[2],P0[3],P0[4],P0[5],     pw0[0]=PKW(P0,0), pw0[1]=PKW(P0,2), pw0); \
    VRD(4); SBAR(); GAPA(C1=__builtin_amdgcn_mfma_f32_32x32x16_bf16(kf[1],qr[0],negm,0,0,0), P0[6],P0[7],P0[8],P0[9],     pw0[2]=PKW(P0,4), pw0[3]=PKW(P0,6), pw0); \
    VRD(1); SBAR(); GAPA(C0=__builtin_amdgcn_mfma_f32_32x32x16_bf16(kf[2],qr[1],C0,0,0,0),   P0[10],P0[11],P0[12],P0[13], pw1[0]=PKW(P0,8), pw1[1]=PKW(P0,10), pw1); \
    VRD(5); SBAR(); GAPA(C1=__builtin_amdgcn_mfma_f32_32x32x16_bf16(kf[3],qr[1],C1,0,0,0),   P0[14],P0[15],P1[0],P1[1],   pw1[2]=PKW(P0,12),pw1[3]=PKW(P0,14), pw1); \
    VRD(2); SBAR(); GAPA(C0=__builtin_amdgcn_mfma_f32_32x32x16_bf16(kf[4],qr[2],C0,0,0,0),   P1[2],P1[3],P1[4],P1[5],     pw2[0]=PKW(P1,0), pw2[1]=PKW(P1,2), pw2); \
    VRD(6); SBAR(); GAPA(C1=__builtin_amdgcn_mfma_f32_32x32x16_bf16(kf[5],qr[2],C1,0,0,0),   P1[6],P1[7],P1[8],P1[9],     pw2[2]=PKW(P1,4), pw2[3]=PKW(P1,6), pw2); \
    VRD(3); SBAR(); GAPA(C0=__builtin_amdgcn_mfma_f32_32x32x16_bf16(kf[6],qr[3],C0,0,0,0),   P1[10],P1[11],P1[12],P1[13], pw3[0]=PKW(P1,8), pw3[1]=PKW(P1,10), pw3); \
    VRD(7); SBAR(); GAPA(C1=__builtin_amdgcn_mfma_f32_32x32x16_bf16(kf[7],qr[3],C1,0,0,0),   P1[14],P1[15],0.f,0.f,       pw3[2]=PKW(P1,12),pw3[3]=PKW(P1,14), pw3); \
    l_reg+=sacc; \
    if(GK){DMA_K((t)+3,sl_cur);} if(GV){DMA_V((t)+1,sl_next);} \
    CMASK(C0,C1,t); \
    { float a=MX3(C0[0],C0[1],C1[0]),b=MX3(C0[2],C0[3],C1[1]); a=MX3(a,C1[2],C1[3]); \
      _Pragma("unroll") for(int r=4;r<16;r+=4){a=MX3(a,C0[r],C0[r+1]);b=MX3(b,C0[r+2],C0[r+3]);a=MX3(a,C1[r],C1[r+1]);b=MX3(b,C1[r+2],C1[r+3]);} \
      float rm=__builtin_fmaxf(a,b); { auto rr=__builtin_amdgcn_permlane32_swap(__float_as_uint(rm),__float_as_uint(rm),false,false); rm=__builtin_fmaxf(__uint_as_float(rr[0]),__uint_as_float(rr[1])); } \
      resc=false; \
      if(__builtin_expect(__any(rm>(float)THRL),0)){ const float dl=__builtin_fmaxf(rm,0.f); mhat+=dl; \
        _Pragma("unroll") for(int r=0;r<16;++r){C0[r]-=dl;C1[r]-=dl;} \
        _Pragma("unroll") for(int r=0;r<16;++r)negm[r]=pc-mhat; asm volatile("":"+v"(negm)); \
        const float f=__builtin_amdgcn_exp2f(-dl); l_reg*=f; if(hi==0)wsf[r32]=f; resc=true; } } \
    SBAR(); \
    GAPB(o[0]=__builtin_amdgcn_mfma_f32_32x32x16_bf16(PAF(0),VFR(0),o[0],0,0,0), C0,0); \
    GAPB(o[1]=__builtin_amdgcn_mfma_f32_32x32x16_bf16(PAF(0),VFR(4),o[1],0,0,0), C0,4); \
    KRD(GL,0); GAPB(o[0]=__builtin_amdgcn_mfma_f32_32x32x16_bf16(PAF(1),VFR(1),o[0],0,0,0), C0,8); \
    KRD(GL,1); GAPB(o[1]=__builtin_amdgcn_mfma_f32_32x32x16_bf16(PAF(1),VFR(5),o[1],0,0,0), C0,12); \
    KRD(GL,2); GAPB(o[0]=__builtin_amdgcn_mfma_f32_32x32x16_bf16(PAF(2),VFR(2),o[0],0,0,0), C1,0); \
    KRD(GL,3); GAPB(o[1]=__builtin_amdgcn_mfma_f32_32x32x16_bf16(PAF(2),VFR(6),o[1],0,0,0), C1,4); \
    GAPB(o[0]=__builtin_amdgcn_mfma_f32_32x32x16_bf16(PAF(3),VFR(3),o[0],0,0,0), C1,8); \
    GAPB(o[1]=__builtin_amdgcn_mfma_f32_32x32x16_bf16(PAF(3),VFR(7),o[1],0,0,0), C1,12); \
    }while(0)
  int t=1;
  for(;t+5<NT;t+=2){
    STEP(pB0,pB1,pA0,pA1,t,true,true,true);     WAIT_BAR(2); RESC(); ROT();
    STEP(pA0,pA1,pB0,pB1,t+1,true,true,true);   WAIT_BAR(2); RESC(); ROT();
  }
  #define ENDW(tt) do{ if((tt)+3<NT){WAIT_BAR(2);} else if((tt)+2<NT){WAIT_BAR(1);} else {WAIT_BAR(0);} }while(0)
  for(;t+1<NT;t+=2){
    STEP(pB0,pB1,pA0,pA1,t,(t+3<NT),(t+1<NT),(t+1<NT));       ENDW(t);   RESC(); ROT();
    STEP(pA0,pA1,pB0,pB1,t+1,(t+4<NT),(t+2<NT),(t+2<NT));     ENDW(t+1); RESC(); ROT();
  }
  STEP(pB0,pB1,pA0,pA1,NT-1,false,false,false); RESC();
  { float sacc=pB0[0]+pB0[1]; _Pragma("unroll") for(int r=2;r<16;++r)sacc+=pB0[r]; _Pragma("unroll") for(int r=0;r<16;++r)sacc+=pB1[r]; l_reg+=sacc;
    pw0=(u32x4){PKW(pB0,0),PKW(pB0,2),PKW(pB0,4),PKW(pB0,6)};pw1=(u32x4){PKW(pB0,8),PKW(pB0,10),PKW(pB0,12),PKW(pB0,14)};pw2=(u32x4){PKW(pB1,0),PKW(pB1,2),PKW(pB1,4),PKW(pB1,6)};pw3=(u32x4){PKW(pB1,8),PKW(pB1,10),PKW(pB1,12),PKW(pB1,14)};
    SBAR(); pv(o,vb0+sl_cur,PAF(0),PAF(1),PAF(2),PAF(3)); }
  #undef PKW
  #undef PAF
  #undef VFR
  #undef PIN
  #undef MX3
  #undef GAPA
  #undef GAPB
  #undef EX
  #undef VRD
  #undef KRD
  #undef STEP
  #undef BIASADD
  #undef SETPC
  #undef ENDW
  {auto rr=__builtin_amdgcn_permlane32_swap(__float_as_uint(l_reg),__float_as_uint(l_reg),false,false);l_reg=__uint_as_float(rr[0])+__uint_as_float(rr[1]);}
  if(hi==0)wsf[32+r32]=l_reg;asm volatile("s_waitcnt lgkmcnt(0)":::"memory");
  float rli[16];
  #pragma unroll
  for(int r=0;r<16;++r)rli[r]=__builtin_amdgcn_rcpf(wsf[32+crow(r,hi)]);
  if constexpr(!BIAS){ bf16*Ow=Ob+(long)(wid*QBLK)*OPITCH;
    bf16*stg=(bf16*)(shm+LDS_OST)+wid*2048;
    #pragma unroll
    for(int r=0;r<16;++r){const int orow=crow(r,hi);
      #pragma unroll
      for(int d0=0;d0<2;++d0)stg[orow*64+d0*32+r32]=__float2bfloat16(o[d0][r]*rli[r]);}
    asm volatile("s_waitcnt lgkmcnt(0)":::"memory");
    #pragma unroll
    for(int i=0;i<4;++i){const int row=i*8+(lane>>3),ch=lane&7; const u32x4 v=*(const u32x4*)(stg+row*64+ch*8); *(u32x4*)(Ow+(long)row*OPITCH+ch*8)=v;} }
  else { float*Sp=Sw+scol+r32;
    #pragma unroll
    for(int r=0;r<16;++r){const int orow=crow(r,hi);
      #pragma unroll
      for(int d0=0;d0<2;++d0){ float*p=Sp+orow*128+d0*32; const float v=o[d0][r]*rli[r]; if(lam==0.f)*p=v; else *p=*p-lam*v; } } }
  asm volatile("s_waitcnt lgkmcnt(0)\n\ts_barrier":::"memory");
  #undef DMA_K
  #undef DMA_V
  #undef CMASK
  #undef START
  #undef RESC
  #undef ROT
}
#undef SBAR
#undef WAIT_BAR
}

__device__ __forceinline__ void transpose_item(const float* W, int K, int N, bf16* WT, int k0, int n0, int drow0, LAS float* scr, int lane) {
#pragma unroll 8
    for (int i = 0; i < 32; ++i) { const int kk = 2 * i + (lane >> 5); scr[kk * 33 + (lane & 31)] = W[(size_t)(k0 + kk) * N + n0 + (lane & 31)]; }
    asm volatile("s_waitcnt lgkmcnt(0)" ::: "memory");
    const int c = lane & 7;
#pragma unroll
    for (int j = 0; j < 4; ++j) { const int n = (lane >> 3) + 8 * j; const LAS float* s = scr + (8 * c) * 33 + n;
        u32x4 o; o.x = pk2(s[0 * 33], s[1 * 33]); o.y = pk2(s[2 * 33], s[3 * 33]); o.z = pk2(s[4 * 33], s[5 * 33]); o.w = pk2(s[6 * 33], s[7 * 33]);
        *(u32x4*)(WT + (size_t)(drow0 + n) * K + k0 + 8 * c) = o; }
    asm volatile("s_waitcnt lgkmcnt(0)" ::: "memory");
}

__global__ void __launch_bounds__(NTHR, 2) fwd(Args args) {
    extern __shared__ __attribute__((aligned(16))) unsigned char lds_raw[];
    LAS unsigned char* lds = (LAS unsigned char*)lds_raw;
    volatile LAS unsigned* MISC = (volatile LAS unsigned*)(lds + MISC_OFF);
    const int tid = threadIdx.x, lane = tid & 63, wave = __builtin_amdgcn_readfirstlane(tid >> 6);
    const int G = gridDim.x, bid = blockIdx.x;
    unsigned char* ws = args.ws;
    unsigned* ctl = (unsigned*)(ws + WS_CTL);
    for (int u = tid; u < 32; u += NTHR) MISC[u] = 0u;
    __syncthreads();
    XcdBarrier bar; bar.bar = ctl + CW_BAR; bar.x = 0; bar.st = nullptr;
    if (MK_N_LAUNCHES == 1) bar = xcd_barrier_post(ctl + CW_BAR, MISC + 8);
    const int lo = args.ph_lo, hi = args.ph_hi;
#define IN(k) (lo <= (k) && (k) < hi)
#define SEAM(k) do { if (IN(k) && IN((k) + 1)) xcd_barrier(bar); } while (0)

    const float* x = args.in[I_X];
    float* out = args.out;
    float* mod = (float*)(ws + WS_MOD);
    int* tokE = (int*)(ws + WS_TOKE); float* tokW = (float*)(ws + WS_TOKW); int* tokP = (int*)(ws + WS_TOKP);
    int* list = (int*)(ws + WS_LIST);
    bf16* WinT = (bf16*)(ws + WS_WIN); bf16* WoutT = (bf16*)(ws + WS_WOUT); bf16* WguT = (bf16*)(ws + WS_WGU); bf16* WdT = (bf16*)(ws + WS_WD);
    bf16* H = (bf16*)(ws + WS_H); bf16* PROJ = (bf16*)(ws + WS_PROJ); bf16* MIX = (bf16*)(ws + WS_MIX);
    bf16* HID = (bf16*)(ws + WS_HID); bf16* YS = (bf16*)(ws + WS_YS);
    const int gw = bid * NWAVES + wave, NGW = G * NWAVES;
    const int vcu = (G % 8 == 0) ? (bid % 8) * (G / 8) + bid / 8 : bid;

    if (IN(0)) {
        const float* c = args.in[I_C]; const float* w_ada = args.in[I_WADA]; const float* b_ada = args.in[I_BADA];
        if (bid < 192) {
            LAS float* sl = (LAS float*)lds;
            LAS f32x4* part = (LAS f32x4*)(lds + 32768);
            for (int i = tid; i < NB * DM; i += NTHR) { const float v = c[i]; sl[i] = v / (1.f + __expf(-v)); }
            __syncthreads();
            for (int item = bid; item < 192; item += G) {
                const int rg = tid >> 3, ch = tid & 7;
                const float* wp = w_ada + (size_t)rg * 6144 + item * 32 + ch * 4;
                f32x4 wv[16];
#pragma unroll
                for (int i = 0; i < 16; ++i) wv[i] = *(const f32x4*)(wp + (size_t)i * 64 * 6144);
                f32x4 acc[NB];
#pragma unroll
                for (int b = 0; b < NB; ++b) acc[b] = (f32x4){0.f, 0.f, 0.f, 0.f};
#pragma unroll
                for (int i = 0; i < 16; ++i)
#pragma unroll
                    for (int b = 0; b < NB; ++b) acc[b] += wv[i] * sl[b * DM + rg + 64 * i];
#pragma unroll
                for (int b = 0; b < NB; ++b) part[(rg * NB + b) * 8 + ch] = acc[b];
                __syncthreads();
                if (tid < 64) { const int b = tid >> 3, ch2 = tid & 7; f32x4 sum = (f32x4){0.f, 0.f, 0.f, 0.f};
                    for (int r = 0; r < 64; ++r) sum += part[(r * NB + b) * 8 + ch2];
                    const f32x4 bb = *(const f32x4*)(b_ada + item * 32 + ch2 * 4);
                    *(f32x4*)(mod + b * 6144 + item * 32 + ch2 * 4) = sum + bb; }
                __syncthreads();
            }
        }
        __syncthreads();
        LAS float* scr = (LAS float*)(lds + wave * 16384);
        constexpr int I_IN = 1152, I_OUT = 512, I_EXP = 768, NITEMS = I_IN + I_OUT + NEXP * I_EXP;
        for (int it = gw; it < NITEMS; it += NGW) {
            int r = it;
            if (r < I_IN) { const int kb = r / 72, nb = r % 72; transpose_item(args.in[I_WIN], DM, INC, WinT, 64 * kb, 32 * nb, 32 * nb, scr, lane); continue; } r -= I_IN;
            if (r < I_OUT) { const int kb = r / 32, nb = r % 32; transpose_item(args.in[I_WOUT], DM, DM, WoutT, 64 * kb, 32 * nb, 32 * nb, scr, lane); continue; } r -= I_OUT;
            const int e = r / I_EXP; r -= e * I_EXP;
            if (r < 256) { const int kb = r / 16, nb = r % 16, j0 = 32 * nb;
                transpose_item(args.in[I_WGATE] + (size_t)e * DM * DEXP, DM, DEXP, WguT + (size_t)e * 1024 * 1024, 64 * kb, j0, (j0 >> 7) * 256 + (j0 & 127), scr, lane); continue; } r -= 256;
            if (r < 256) { const int kb = r / 16, nb = r % 16, j0 = 32 * nb;
                transpose_item(args.in[I_WUP] + (size_t)e * DM * DEXP, DM, DEXP, WguT + (size_t)e * 1024 * 1024, 64 * kb, j0, (j0 >> 7) * 256 + 128 + (j0 & 127), scr, lane); continue; } r -= 256;
            { const int kb = r / 32, nb = r % 32;
                transpose_item(args.in[I_WDOWN] + (size_t)e * DEXP * DM, DEXP, DM, WdT + (size_t)e * 1024 * 512, 64 * kb, 32 * nb, 32 * nb, scr, lane); }
        }
    }
    SEAM(0);

    if (IN(1)) {
        int lane_o = tid & 63; asm volatile("" : "+v"(lane_o)); const int lane = lane_o;
        for (int ck = bid; ck < T / 64; ck += G) {
            const int m0 = ck * 64 + wave * 8, b = m0 / SEQ;
            f32x4 sh[4], sc[4];
#pragma unroll
            for (int j = 0; j < 4; ++j) { sh[j] = ((const f32x4*)(mod + b * 6144))[64 * j + lane]; sc[j] = ((const f32x4*)(mod + b * 6144 + 1024))[64 * j + lane] + 1.f; }
            f32x4 nx[4];
#pragma unroll
            for (int j = 0; j < 4; ++j) nx[j] = ((const f32x4*)(x + (size_t)m0 * DM))[64 * j + lane];
#pragma unroll 1
            for (int r = 0; r < 8; ++r) {
                const int m = m0 + r;
                f32x4 v[4]; float s = 0.f;
#pragma unroll
                for (int j = 0; j < 4; ++j) { v[j] = nx[j]; s += (v[j].x + v[j].y) + (v[j].z + v[j].w); }
                if (r < 7) {
#pragma unroll
                    for (int j = 0; j < 4; ++j) nx[j] = ((const f32x4*)(x + (size_t)(m + 1) * DM))[64 * j + lane]; }
                const float mean = wave_sum(s) * (1.f / DM); float s2 = 0.f;
#pragma unroll
                for (int j = 0; j < 4; ++j) { v[j] = v[j] - mean; s2 += (v[j].x * v[j].x + v[j].y * v[j].y) + (v[j].z * v[j].z + v[j].w * v[j].w); }
                const float rstd = 1.f / sqrtf(wave_sum(s2) * (1.f / DM) + LN_EPS);
                unsigned long long* o8 = (unsigned long long*)(H + (size_t)m * DM) + lane;
#pragma unroll
                for (int j = 0; j < 4; ++j) { const f32x4 h = v[j] * rstd * sc[j] + sh[j];
                    o8[64 * j] = (unsigned long long)pk2(h.x, h.y) | ((unsigned long long)pk2(h.z, h.w) << 32); }
            }
        }
    }
    SEAM(1);

    if (IN(2)) {
        pg8::Gemm g{H, WinT, DM}; pg8::StaticOrder S; S.init(T, INC, G, bid);
        pg8::EpiProj E{PROJ};
        pg8::gemm_phase<pg8::EpiProj, pg8::StaticOrder, true, false>(lds, g, S, E, nullptr);
    }
    SEAM(2);

    if (IN(3)) {
        int lane_o = tid & 63; asm volatile("" : "+v"(lane_o)); const int lane = lane_o;
        const float* qg = args.in[I_QNG]; const float* kg = args.in[I_KNG];
        const int hl = lane >> 5, p = lane & 31;
        for (int m = gw; m < T; m += NGW) {
            const int s = m % SEQ; const float pos = (p < 16) ? (float)(s / 64) : (float)(s % 64);
            const float freq = powf(10000.f, -(float)(2 * (p & 15)) / 32.f);
            const float ang = pos * freq; const float cs = cosf(ang), sn = sinf(ang);
#pragma unroll
            for (int it = 0; it < 5; ++it) {
                const int hd = it * 2 + hl;
                const bool isq = hd < 8;
                bf16* ptr = PROJ + (size_t)m * INC + (isq ? C_GQ + hd * 64 : C_GK + (hd - 8) * 64) + 2 * p;
                const unsigned w = *(const unsigned*)ptr;
                const float x1 = bf2f((unsigned short)(w & 0xffffu)), x2 = bf2f((unsigned short)(w >> 16));
                const float ss = half_sum(x1 * x1 + x2 * x2);
                const float r = 1.f / sqrtf(ss * (1.f / 64.f) + RMS_EPS);
                const float* g = isq ? qg : kg;
                const float y1 = x1 * r * g[2 * p], y2 = x2 * r * g[2 * p + 1];
                float o1 = y1 * cs - y2 * sn, o2 = y1 * sn + y2 * cs;
                if (isq) { o1 *= C2; o2 *= C2; }
                *(unsigned*)ptr = pk2(o1, o2);
            }
        }
    }
    SEAM(3);

    if (IN(4)) {
        char* shm = (char*)lds_raw;
        const float* relb = args.in[I_RELB];
        float lam;
        { float d1 = 0.f, d2 = 0.f;
          for (int i = 0; i < 64; ++i) { d1 += args.in[I_LQ1][i] * args.in[I_LK1][i]; d2 += args.in[I_LQ2][i] * args.in[I_LK2][i]; }
          lam = expf(d1) - expf(d2) + LAMBDA_INIT; }
        float* Sw = out + ((size_t)bid * NWAVES + wave) * 4096;
        const attn::bf16* PJ = (const attn::bf16*)PROJ;
        for (int id = vcu; id < 256; id += G) {
            const int b = id >> 5, h = (id >> 3) & 3, qb = id & 7;
            __syncthreads();
            { int t2 = (int)threadIdx.x; asm volatile("" : "+v"(t2));
              LAS float* tb = (LAS float*)(lds + attn::LDS_TB); const int rel = t2 - 256; const int n = rel < 0 ? -rel : rel;
              int bk; if (n < 8) bk = n; else { const int l2 = 31 - __clz(n * n); bk = 8 + l2 - 6; if (bk > 15) bk = 15; }
              if (rel > 0) bk += 16;
              tb[t2] = (relb[bk * 4 + h] - relb[15 * 4 + h]) * LOG2E; }
            __syncthreads();
            const float dlt = (relb[31 * 4 + h] - relb[15 * 4 + h]) * LOG2E;
            const size_t row0 = (size_t)b * SEQ + qb * 256;
#pragma unroll 1
            for (int ps = 0; ps < 4; ++ps) { const int cm = ps >> 1, vh = ps & 1;
                attn::attn_run<8, true>(PJ + row0 * INC + C_DQ + h * 128 + cm * 64, PJ + (size_t)b * SEQ * INC + C_DK + h * 128 + cm * 64, PJ + (size_t)b * SEQ * INC + C_DV + h * 128 + vh * 64,
                                        nullptr, Sw, vh * 64, cm ? lam : 0.f, dlt, qb * 256, shm); }
            asm volatile("s_waitcnt vmcnt(0)" ::: "memory");
            { int ln = (int)__builtin_amdgcn_mbcnt_hi(~0u, __builtin_amdgcn_mbcnt_lo(~0u, 0u)); asm volatile("" : "+v"(ln));
              const float* sg = args.in[I_SUBLN]; const float g0 = sg[2 * ln], g1 = sg[2 * ln + 1];
              const float* Sr = Sw + 2 * ln; bf16* Mr = MIX + (row0 + wave * 32) * DM + h * 128 + 2 * ln;
#pragma unroll 4
              for (int r = 0; r < 32; ++r) { const float d0 = Sr[r * 128], d1 = Sr[r * 128 + 1];
                const float ss = wave_sum(d0 * d0 + d1 * d1); const float rr = (1.f - LAMBDA_INIT) / sqrtf(ss * (1.f / 128.f) + RMS_EPS);
                *(unsigned*)(Mr + (size_t)r * DM) = pk2(d0 * rr * g0, d1 * rr * g1); } }
        }
        for (int id2 = vcu; id2 < 256; id2 += G)
#pragma unroll 1
            for (int i = 0; i < 2; ++i) { const int id = 2 * id2 + i; const int b = id >> 6, hd = (id >> 3) & 7, qb = id & 7;
                const size_t row0 = (size_t)b * SEQ + qb * 256;
                attn::attn_run<8, false>(PJ + row0 * INC + C_GQ + hd * 64, PJ + (size_t)b * SEQ * INC + C_GK + (hd >> 2) * 64, PJ + (size_t)b * SEQ * INC + C_GV + (hd >> 2) * 64,
                                         (attn::bf16*)MIX + row0 * DM + 512 + hd * 64, nullptr, 0, 0.f, 0.f, 0, shm); }
    }
    SEAM(4);

    if (IN(5)) {
        pg8::Gemm g{MIX, WoutT, DM}; pg8::StaticOrder S; S.init(T, DM, G, bid);
        pg8::EpiOut E{out, x, mod};
        pg8::gemm_phase<pg8::EpiOut, pg8::StaticOrder, false, false>(lds, g, S, E, nullptr);
    }
    SEAM(5);

    if (IN(6)) {
        int lane_o = tid & 63; asm volatile("" : "+v"(lane_o)); const int lane = lane_o;
        const float* g1v = args.in[I_LN1G]; const float* b1v = args.in[I_LN1B];
        const float* wrg = args.in[I_WRG]; const float* brg = args.in[I_BRG]; const float* wre = args.in[I_WRE]; const float* bre = args.in[I_BRE];
        LAS f32x4* wre4 = (LAS f32x4*)lds; LAS f32x4* wrg4 = (LAS f32x4*)(lds + AUX_OFF);
        LAS int* lcnt = (LAS int*)(lds + MISC_OFF + 256);
        LAS int* lsel = (LAS int*)(lds + MISC_OFF + 384);
        __syncthreads();
        for (int idx = tid; idx < 4 * 1024 * 2; idx += NTHR) { const int g = idx >> 11, col = (idx & 2047) >> 1, pl = idx & 1;
            wre4[(g * 2 + pl) * 1024 + (col & 3) * 256 + (col >> 8) * 64 + ((col & 255) >> 2)] = *(const f32x4*)(wre + (size_t)idx * 4); }
        for (int col = tid; col < 1024; col += NTHR) wrg4[(col & 3) * 256 + (col >> 8) * 64 + ((col & 255) >> 2)] = *(const f32x4*)(wrg + col * 4);
        f32x4 gg[4], bb[4];
#pragma unroll
        for (int j = 0; j < 4; ++j) { gg[j] = ((const f32x4*)g1v)[64 * j + lane]; bb[j] = ((const f32x4*)b1v)[64 * j + lane]; }
        for (int ck = bid; ck < T / 64; ck += G) {
            if (tid < 32) lcnt[tid] = 0;
            __syncthreads();
            const int m0 = ck * 64 + wave * 8, b = m0 / SEQ;
            f32x4 sh[4], sc[4];
#pragma unroll
            for (int j = 0; j < 4; ++j) { sh[j] = ((const f32x4*)(mod + b * 6144 + 3072))[64 * j + lane]; sc[j] = ((const f32x4*)(mod + b * 6144 + 4096))[64 * j + lane] + 1.f; }
            f32x4 nx[4];
#pragma unroll
            for (int j = 0; j < 4; ++j) nx[j] = ((const f32x4*)(out + (size_t)m0 * DM))[64 * j + lane];
#pragma unroll 1
            for (int r = 0; r < 8; ++r) {
                const int m = m0 + r;
                f32x4* yr = (f32x4*)(out + (size_t)m * DM) + lane;
                f32x4 v[4]; float s = 0.f;
#pragma unroll
                for (int j = 0; j < 4; ++j) { v[j] = nx[j]; s += (v[j].x + v[j].y) + (v[j].z + v[j].w); }
                if (r < 7) {
#pragma unroll
                    for (int j = 0; j < 4; ++j) nx[j] = ((const f32x4*)(out + (size_t)(m + 1) * DM))[64 * j + lane]; }
                float mean = wave_sum(s) * (1.f / DM); float s2 = 0.f;
#pragma unroll
                for (int j = 0; j < 4; ++j) { v[j] = v[j] - mean; s2 += (v[j].x * v[j].x + v[j].y * v[j].y) + (v[j].z * v[j].z + v[j].w * v[j].w); }
                float rstd = 1.f / sqrtf(wave_sum(s2) * (1.f / DM) + LN_EPS);
                s = 0.f;
#pragma unroll
                for (int j = 0; j < 4; ++j) { v[j] = v[j] * rstd * gg[j] + bb[j]; yr[64 * j] = v[j]; s += (v[j].x + v[j].y) + (v[j].z + v[j].w); }
                mean = wave_sum(s) * (1.f / DM); s2 = 0.f;
#pragma unroll
                for (int j = 0; j < 4; ++j) { v[j] = v[j] - mean; s2 += (v[j].x * v[j].x + v[j].y * v[j].y) + (v[j].z * v[j].z + v[j].w * v[j].w); }
                rstd = 1.f / sqrtf(wave_sum(s2) * (1.f / DM) + LN_EPS);
                unsigned long long* o8 = (unsigned long long*)(H + (size_t)m * DM) + lane;
#pragma unroll
                for (int j = 0; j < 4; ++j) { v[j] = v[j] * rstd * sc[j] + sh[j];
                    o8[64 * j] = (unsigned long long)pk2(v[j].x, v[j].y) | ((unsigned long long)pk2(v[j].z, v[j].w) << 32); }
                float lg[4] = {0.f, 0.f, 0.f, 0.f};
#pragma unroll
                for (int j = 0; j < 4; ++j)
#pragma unroll
                    for (int cc = 0; cc < 4; ++cc) { const float hv = v[j][cc]; const f32x4 wg = wrg4[cc * 256 + j * 64 + lane];
#pragma unroll
                        for (int o = 0; o < 4; ++o) lg[o] += hv * wg[o]; }
                float gl[4]; int gs = 0;
#pragma unroll
                for (int o = 0; o < 4; ++o) gl[o] = wave_sum(lg[o]) + brg[o];
                float gmax = gl[0];
#pragma unroll
                for (int o = 1; o < 4; ++o) if (gl[o] > gmax) { gmax = gl[o]; gs = o; }
                gs = __builtin_amdgcn_readfirstlane(gs);
                float den = 0.f;
#pragma unroll
                for (int o = 0; o < 4; ++o) den += expf(gl[o] - gmax);
                const float pg = 1.f / den;
                float el[8] = {0.f, 0.f, 0.f, 0.f, 0.f, 0.f, 0.f, 0.f};
                { const LAS f32x4* wb = wre4 + gs * 2048 + lane;
#pragma unroll
                  for (int j = 0; j < 4; ++j)
#pragma unroll
                    for (int cc = 0; cc < 4; ++cc) { const float hv = v[j][cc]; const f32x4 w0 = wb[cc * 256 + j * 64], w1 = wb[1024 + cc * 256 + j * 64];
#pragma unroll
                        for (int o = 0; o < 4; ++o) { el[o] += hv * w0[o]; el[4 + o] += hv * w1[o]; } } }
#pragma unroll
                for (int o = 0; o < 8; ++o) el[o] = wave_sum(el[o]) + bre[gs * 8 + o];
                int i1 = 0; float v1 = el[0];
#pragma unroll
                for (int o = 1; o < 8; ++o) if (el[o] > v1) { v1 = el[o]; i1 = o; }
                int i2 = -1; float v2 = -3.0e38f;
#pragma unroll
                for (int o = 0; o < 8; ++o) if (o != i1 && (i2 < 0 || el[o] > v2)) { v2 = el[o]; i2 = o; }
                if (lane == 0) {
                    const float ex = expf(v2 - v1);
                    const int e1 = gs * 8 + i1, e2 = gs * 8 + i2;
                    const int k1 = __hip_atomic_fetch_add(lcnt + e1, 1, __ATOMIC_RELAXED, __HIP_MEMORY_SCOPE_WORKGROUP);
                    const int k2 = __hip_atomic_fetch_add(lcnt + e2, 1, __ATOMIC_RELAXED, __HIP_MEMORY_SCOPE_WORKGROUP);
                    lsel[(wave * 8 + r) * 2] = e1 | (k1 << 8); lsel[(wave * 8 + r) * 2 + 1] = e2 | (k2 << 8);
                    tokE[2 * m] = e1; tokE[2 * m + 1] = e2; tokW[2 * m] = pg / (1.f + ex); tokW[2 * m + 1] = pg * ex / (1.f + ex);
                }
            }
            __syncthreads();
            if (tid < 32) { const int c = lcnt[tid]; lcnt[tid] = c ? (int)atomicAdd(ctl + CW_CNT + 64 * tid, (unsigned)c) : 0; }
            __syncthreads();
            if (tid < 128) { const int sel = lsel[tid]; const int e = sel & 255, pos = lcnt[e] + (sel >> 8); const int m = ck * 64 + (tid >> 1);
                list[(size_t)e * T + pos] = m; tokP[2 * m + (tid & 1)] = pos; }
            __syncthreads();
        }
    }
    SEAM(6);

    LAS int* toff = (LAS int*)(lds + AUX_OFF);
    if (hi > 7) {
        __syncthreads();
        if (tid == 0) { int acc = 0; for (int e = 0; e < NEXP; ++e) { const int cnt = (int)__hip_atomic_load(ctl + CW_CNT + 64 * e, __ATOMIC_RELAXED, __HIP_MEMORY_SCOPE_AGENT);
            toff[e] = acc; toff[64 + e] = cnt; acc += (cnt + 255) >> 8; } toff[32] = acc; }
        __syncthreads();
    }

    if (IN(7)) {
        LAS int* tokTab = (LAS int*)(lds + AUX_OFF + 4096);
        pg8::ExpertOrder S{toff, G, vcu};
        { pg8::Unit u;
          for (int i = 0; i < 4 && S.next(i, u); ++i) { const int e = u.pn >> 2; const int cnt = toff[64 + e]; const int r0 = (u.pm - toff[e]) * 256;
              for (int r = tid; r < 256; r += NTHR) tokTab[i * 256 + r] = (r0 + r < cnt) ? list[(size_t)e * T + r0 + r] : 0; } }
        __syncthreads();
        pg8::Gemm g{H, WguT, DM};
        pg8::EpiGateUp E{HID};
        pg8::gemm_phase<pg8::EpiGateUp, pg8::ExpertOrder, true, true>(lds, g, S, E, tokTab);
    }
    SEAM(7);

    if (IN(8)) {
        pg8::ExpertOrder S{toff, G, vcu};
        pg8::Gemm g{HID, WdT, DEXP};
        pg8::EpiDown E{YS};
        pg8::gemm_phase<pg8::EpiDown, pg8::ExpertOrder, true, false>(lds, g, S, E, nullptr);
    }
    SEAM(8);

    if (IN(9)) {
        int lane_o = tid & 63; asm volatile("" : "+v"(lane_o)); const int lane = lane_o;
        const float* g2v = args.in[I_LN2G]; const float* b2v = args.in[I_LN2B];
        f32x4 gg[4], bb[4];
#pragma unroll
        for (int j = 0; j < 4; ++j) { gg[j] = ((const f32x4*)g2v)[64 * j + lane]; bb[j] = ((const f32x4*)b2v)[64 * j + lane]; }
        for (int ck = bid; ck < T / 64; ck += G) {
            const int m0 = ck * 64 + wave * 8, b = m0 / SEQ;
            f32x4 g2[4];
#pragma unroll
            for (int j = 0; j < 4; ++j) g2[j] = ((const f32x4*)(mod + b * 6144 + 5120))[64 * j + lane] + 1.f;
            int myslot = 0; float myw = 0.f;
            if (lane < 16) { const int idx = 2 * m0 + lane; myslot = toff[tokE[idx]] * 256 + tokP[idx]; myw = tokW[idx]; }
            f32x4 nx[4]; u32x2 na[4], nb[4];
            { const int sa = __shfl(myslot, 0), sb = __shfl(myslot, 1);
#pragma unroll
              for (int j = 0; j < 4; ++j) { nx[j] = ((const f32x4*)(out + (size_t)m0 * DM))[64 * j + lane]; na[j] = ((const u32x2*)(YS + (size_t)sa * DM))[64 * j + lane]; nb[j] = ((const u32x2*)(YS + (size_t)sb * DM))[64 * j + lane]; } }
#pragma unroll 1
            for (int r = 0; r < 8; ++r) {
                const int m = m0 + r;
                const float wa = __shfl(myw, 2 * r), wb = __shfl(myw, 2 * r + 1);
                f32x4 v[4]; float s = 0.f;
#pragma unroll
                for (int j = 0; j < 4; ++j) { const u32x2 a = na[j], bq = nb[j];
                    f32x4 fa, fb;
                    fa.x = bf2f((unsigned short)(a.x & 0xffffu)); fa.y = bf2f((unsigned short)(a.x >> 16)); fa.z = bf2f((unsigned short)(a.y & 0xffffu)); fa.w = bf2f((unsigned short)(a.y >> 16));
                    fb.x = bf2f((unsigned short)(bq.x & 0xffffu)); fb.y = bf2f((unsigned short)(bq.x >> 16)); fb.z = bf2f((unsigned short)(bq.y & 0xffffu)); fb.w = bf2f((unsigned short)(bq.y >> 16));
                    v[j] = nx[j] * ALPHA + g2[j] * (fa * wa + fb * wb); s += (v[j].x + v[j].y) + (v[j].z + v[j].w); }
                if (r < 7) { const int sa = __shfl(myslot, 2 * r + 2), sb = __shfl(myslot, 2 * r + 3);
#pragma unroll
                    for (int j = 0; j < 4; ++j) { nx[j] = ((const f32x4*)(out + (size_t)(m + 1) * DM))[64 * j + lane]; na[j] = ((const u32x2*)(YS + (size_t)sa * DM))[64 * j + lane]; nb[j] = ((const u32x2*)(YS + (size_t)sb * DM))[64 * j + lane]; } }
                const float mean = wave_sum(s) * (1.f / DM); float s2 = 0.f;
#pragma unroll
                for (int j = 0; j < 4; ++j) { v[j] = v[j] - mean; s2 += (v[j].x * v[j].x + v[j].y * v[j].y) + (v[j].z * v[j].z + v[j].w * v[j].w); }
                const float rstd = 1.f / sqrtf(wave_sum(s2) * (1.f / DM) + LN_EPS);
                f32x4* xr = (f32x4*)(out + (size_t)m * DM) + lane;
#pragma unroll
                for (int j = 0; j < 4; ++j) xr[64 * j] = v[j] * rstd * gg[j] + bb[j];
            }
        }
    }
#undef IN
#undef SEAM
}

extern "C" void kernel_launch(void* const* d_in, const int* in_sizes, int n_in, void* d_out, int out_size, void* d_ws, size_t ws_size, hipStream_t stream) {
    static int grid = 0;
    if (grid == 0) {
        if (n_in != 25 || out_size != T * DM || ws_size < WS_END) { fprintf(stderr, "kernel_launch: unexpected shapes (n_in %d out %d ws %zu)\n", n_in, out_size, ws_size); grid = -1; return; }
        int dev = 0, cus = 0, per_cu = 0;
        if (hipGetDevice(&dev) != hipSuccess || hipDeviceGetAttribute(&cus, hipDeviceAttributeMultiprocessorCount, dev) != hipSuccess) { grid = -1; return; }
        if (hipFuncSetAttribute((const void*)fwd, hipFuncAttributeMaxDynamicSharedMemorySize, LDS_BYTES) != hipSuccess) { fprintf(stderr, "kernel_launch: hipFuncSetAttribute failed\n"); grid = -1; return; }
        if (hipOccupancyMaxActiveBlocksPerMultiprocessor(&per_cu, (const void*)fwd, NTHR, LDS_BYTES) != hipSuccess || per_cu < 1) { fprintf(stderr, "kernel_launch: occupancy query says %d\n", per_cu); }
        (void)hipGetLastError();
        grid = cus;
    }
    if (grid < 0) return;
    (void)hipMemsetAsync((char*)d_ws + WS_CTL, 0, CTL_ZERO_BYTES, stream);
    Args a{};
    for (int i = 0; i < 25; ++i) a.in[i] = (const float*)d_in[i];
    a.out = (float*)d_out; a.ws = (unsigned char*)d_ws; a.pad = 0;
    if (MK_N_LAUNCHES == 1) {
        a.ph_lo = 0; a.ph_hi = NPH; a.li = 0;
        hipLaunchKernelGGL(fwd, dim3(grid), dim3(NTHR), LDS_BYTES, stream, a);
    } else {
        for (int p = 0; p < NPH; ++p) for (int rep = 0; rep < ((PROBE_REP == p) ? 2 : 1); ++rep) { a.ph_lo = p; a.ph_hi = p + 1; a.li = p; hipLaunchKernelGGL(fwd, dim3(grid), dim3(NTHR), LDS_BYTES, stream, a); }
    }
}
```

```cpp
#include <hip/hip_runtime.h>
#include <cstdio>
#include <cstdint>
#include <hip/hip_bf16.h>

#ifndef PROBE_REP
#define PROBE_REP -1
#endif
#ifndef MK_N_LAUNCHES
#define MK_N_LAUNCHES 1
#endif

#define GAS __attribute__((address_space(1)))
#define LAS __attribute__((address_space(3)))
typedef unsigned short bf16;
typedef short bf16x8 __attribute__((ext_vector_type(8)));
typedef float f32x4 __attribute__((ext_vector_type(4)));
typedef unsigned u32x4 __attribute__((ext_vector_type(4)));
typedef unsigned u32x2 __attribute__((ext_vector_type(2)));

constexpr int NB = 8, SEQ = 2048, DM = 1024, T = NB * SEQ;
constexpr int INC = 2304;
constexpr int C_DQ = 0, C_DK = 512, C_DV = 1024, C_GQ = 1536, C_GK = 2048, C_GV = 2176;
constexpr int NEXP = 32, DEXP = 512;
constexpr float LN_EPS = 1e-5f, RMS_EPS = 1e-6f;
constexpr float ALPHA = 1.189207115002721f;
constexpr float LAMBDA_INIT = 0.2f;
constexpr float LOG2E = 1.4426950408889634f;
constexpr float C2 = 0.125f * LOG2E;
constexpr int NWAVES = 8, NTHR = 512;
constexpr int NPH = 10;

constexpr size_t MiB = 1u << 20;
constexpr size_t WS_CTL = 0, CTL_ZERO_BYTES = 1 * MiB;
constexpr size_t WS_MOD = 1 * MiB;
constexpr size_t WS_ROPE = 1 * MiB + 512 * 1024;
constexpr size_t WS_TOKE = 2 * MiB;
constexpr size_t WS_TOKW = 2 * MiB + 256 * 1024;
constexpr size_t WS_TOKP = 2 * MiB + 512 * 1024;
constexpr size_t WS_LIST = 4 * MiB;
constexpr size_t WS_WIN = 8 * MiB;
constexpr size_t WS_WOUT = 14 * MiB;
constexpr size_t WS_WGU = 16 * MiB;
constexpr size_t WS_WD = 80 * MiB;
constexpr size_t WS_H = 112 * MiB;
constexpr size_t WS_PROJ = 144 * MiB;
constexpr size_t WS_MIX = 216 * MiB;
constexpr size_t WS_HID = 216 * MiB;
constexpr size_t WS_YS = 112 * MiB;
constexpr size_t WS_END = 256 * MiB;
constexpr int MAXSLOT = 40960;
constexpr int CW_BAR = 4096;
constexpr int CW_CNT = 16384;

__device__ __forceinline__ unsigned f2bf(float f) { unsigned u = __builtin_bit_cast(unsigned, f); return (u + 0x7fffu + ((u >> 16) & 1u)) >> 16; }
__device__ __forceinline__ unsigned pk2(float lo, float hi) { return f2bf(lo) | (f2bf(hi) << 16); }
__device__ __forceinline__ float bf2f(unsigned short u) { return __builtin_bit_cast(float, (unsigned)u << 16); }
template <int CTRL> __device__ __forceinline__ float dpp_f(float v) { return __builtin_bit_cast(float, __builtin_amdgcn_update_dpp(0, __builtin_bit_cast(int, v), CTRL, 0xF, 0xF, true)); }
__device__ __forceinline__ float row16_sum(float v) {
    v += dpp_f<0xB1>(v);
    v += dpp_f<0x4E>(v);
    v += dpp_f<0x141>(v);
    v += dpp_f<0x140>(v);
    return v;
}
__device__ __forceinline__ float half_sum(float v) {
    v = row16_sum(v);
    auto rr = __builtin_amdgcn_permlane16_swap(__float_as_uint(v), __float_as_uint(v), false, false);
    return __uint_as_float(rr[0]) + __uint_as_float(rr[1]);
}
__device__ __forceinline__ float wave_sum(float v) {
    v = half_sum(v);
    auto rr = __builtin_amdgcn_permlane32_swap(__float_as_uint(v), __float_as_uint(v), false, false);
    return __uint_as_float(rr[0]) + __uint_as_float(rr[1]);
}

#define XB_TMO      128
#define XB_XCNT(j)  (256  + 64 * (j))
#define XB_XSUB(j)  (1280 + 64 * (j))
#define XB_XGEN(j)  (2304 + 64 * (j))
#define XB_TOP      3328
#define XB_TOPGEN   3392
#define XCD_BAR_WORDS 3456
#define XB_SPIN_CAP (1u << 18)
__device__ __forceinline__ unsigned xb_ld(unsigned* p)              { return __hip_atomic_load(p, __ATOMIC_RELAXED, __HIP_MEMORY_SCOPE_AGENT); }
__device__ __forceinline__ unsigned xb_add(unsigned* p, unsigned v) { return __hip_atomic_fetch_add(p, v, __ATOMIC_RELAXED, __HIP_MEMORY_SCOPE_AGENT); }
__device__ __forceinline__ unsigned xb_xcc_id() { return (unsigned)__builtin_amdgcn_s_getreg((3 << 11) | 20) & 0xFu; }
#define XB_SPIN(cond, bar) do { unsigned _sp = 0; while (cond) { __builtin_amdgcn_s_sleep(1); \
    if ((++_sp & 255u) == 0u) { if (xb_ld(&(bar)[XB_TMO])) break; if (_sp > XB_SPIN_CAP) { atomicAdd(&(bar)[XB_TMO], 1u); break; } } } } while (0)
struct XcdBarrier { unsigned* bar; unsigned x; volatile LAS unsigned* st; };
__device__ __forceinline__ XcdBarrier xcd_barrier_post(unsigned* bar, volatile LAS unsigned* st) {
    XcdBarrier b; b.bar = bar; b.x = xb_xcc_id(); b.st = st;
    if (threadIdx.x == 0) (void)xb_add(&bar[XB_XCNT(b.x)], 1u);
    return b;
}
__device__ __forceinline__ void xcd_barrier_complete(unsigned* bar, unsigned x, unsigned& nloc, unsigned& nx) {
    const unsigned G = gridDim.x * gridDim.y * gridDim.z;
    unsigned sum, cnt, mine, sp = 0u;
    for (;;) {
        sum = 0u; cnt = 0u; mine = 0u;
#pragma unroll
        for (unsigned j = 0; j < 16; ++j) { const unsigned c = xb_ld(&bar[XB_XCNT(j)]); sum += c; cnt += (c > 0u) ? 1u : 0u; mine = (j == x) ? c : mine; }
        if (sum == G) break;
        __builtin_amdgcn_s_sleep(1);
        if ((++sp & 255u) == 0u) { if (xb_ld(&bar[XB_TMO])) break; if (sp > XB_SPIN_CAP) { atomicAdd(&bar[XB_TMO], 1u); break; } }
    }
    nloc = mine > 0u ? mine : 1u; nx = cnt > 0u ? cnt : 1u;
}
__device__ __forceinline__ void xcd_barrier(const XcdBarrier& b) {
    asm volatile("s_waitcnt vmcnt(0)" ::: "memory");
    __syncthreads();
    if (threadIdx.x == 0) {
        unsigned* bar = b.bar;
        __builtin_amdgcn_s_waitcnt(0);
        unsigned nloc = b.st[0], nx = b.st[1];
        if (nloc == 0u) { xcd_barrier_complete(bar, b.x, nloc, nx); b.st[0] = nloc; b.st[1] = nx; }
        const unsigned old = xb_add(&bar[XB_XSUB(b.x)], 1u);
        const unsigned gen = old / nloc;
        if (old + 1u == (gen + 1u) * nloc) {
            __builtin_amdgcn_fence(__ATOMIC_RELEASE, "agent");
            asm volatile("s_waitcnt vmcnt(0)" ::: "memory");
            const unsigned og = xb_add(&bar[XB_TOP], 1u);
            const unsigned tg = og / nx;
            if (og + 1u == (tg + 1u) * nx) xb_add(&bar[XB_TOPGEN], 1u);
            else XB_SPIN(xb_ld(&bar[XB_TOPGEN]) == tg, bar);
            __builtin_amdgcn_fence(__ATOMIC_ACQUIRE, "agent");
            xb_add(&bar[XB_XGEN(b.x)], 1u);
            asm volatile("s_waitcnt vmcnt(0)" ::: "memory");
        } else {
            XB_SPIN(xb_ld(&bar[XB_XGEN(b.x)]) == gen, bar);
            __builtin_amdgcn_fence(__ATOMIC_ACQUIRE, "agent");
            asm volatile("s_waitcnt vmcnt(0)" ::: "memory");
        }
    }
    __syncthreads();
}

struct Args {
    const float* in[25]; float* out; unsigned char* ws; int ph_lo, ph_hi, li, pad;
};
enum { I_X = 0, I_C, I_WADA, I_BADA, I_WIN, I_LQ1, I_LK1, I_LQ2, I_LK2, I_SUBLN, I_QNG, I_KNG, I_RELB, I_WOUT, I_LN1G, I_LN1B,
       I_WRG, I_BRG, I_WRE, I_BRE, I_WGATE, I_WUP, I_WDOWN, I_LN2G, I_LN2B };

constexpr int LDS_BYTES = 148480;
constexpr int AUX_OFF = 131072;
constexpr int MISC_OFF = 147456;

__device__ __forceinline__ void wave_gemm64(const bf16* (&arow)[4], const bf16* (&brow)[4], int K, f32x4 (&acc)[4][4], int lane) {
    const int kq = (lane >> 4) * 8;
#pragma unroll
    for (int i = 0; i < 4; ++i)
#pragma unroll
        for (int j = 0; j < 4; ++j) acc[i][j] = (f32x4){0.f, 0.f, 0.f, 0.f};
    for (int k0 = 0; k0 < K; k0 += 32) {
        bf16x8 a[4], b[4];
#pragma unroll
        for (int i = 0; i < 4; ++i) a[i] = *(const bf16x8*)(arow[i] + k0 + kq);
#pragma unroll
        for (int j = 0; j < 4; ++j) b[j] = *(const bf16x8*)(brow[j] + k0 + kq);
#pragma unroll
        for (int i = 0; i < 4; ++i)
#pragma unroll
            for (int j = 0; j < 4; ++j) acc[i][j] = __builtin_amdgcn_mfma_f32_16x16x32_bf16(a[i], b[j], acc[i][j], 0, 0, 0);
    }
}


namespace pg8 {
constexpr int BM = 256, BK = 64, HALF = 128, HTB = HALF * BK * 2, STAGE_BYTES = 8 * HTB, NXCD = 8, WGM = 8;
__host__ __device__ __forceinline__ int lds_byte(int r, int c) { const int st = (r >> 4) * 2 + (c >> 5), rr = r & 15, cc = c & 31, ob = rr * 64 + cc * 2; return st * 1024 + (ob ^ (((ob >> 9) & 1) << 5)); }
__host__ __device__ __forceinline__ void stage_rc(int b, int& R, int& C) { const int st = b / 1024, sb = b % 1024, swz = sb ^ (((sb >> 9) & 1) << 5); R = (st >> 1) * 16 + swz / 64; C = (st & 1) * 32 + (swz % 64) / 2; }
__host__ __device__ __forceinline__ int perm32(int rho) { const int n = rho >> 4, i = rho & 15; return 8 * (i >> 2) + 4 * n + (i & 3); }
struct Unit { int pm, pn; };
struct Gemm { const bf16* A; const bf16* Bt; int K; };
struct StaticOrder {
    int nM, nN, nwg, G, c;
    __device__ void init(int M, int N, int G_, int c_) { nM = M / BM; nN = N / BM; nwg = nM * nN; G = G_; c = c_; }
    __device__ bool next(int i, Unit& u) const {
        const long L = (long)i * G + c; if (L >= nwg) return false;
        int wgid = (int)L; { const int q = nwg / NXCD, r = nwg % NXCD, xcd = wgid % NXCD, off = wgid / NXCD; wgid = (xcd < r ? xcd * (q + 1) : r * (q + 1) + (xcd - r) * q) + off; }
        const int nig = WGM * nN, gid = wgid / nig, fm = gid * WGM, gsz = (nM - fm) < WGM ? (nM - fm) : WGM;
        u.pm = fm + ((wgid % nig) % gsz); u.pn = (wgid % nig) / gsz; return true;
    }
};
__device__ __forceinline__ unsigned cvt_pk_bf16(float lo, float hi) { unsigned r; asm volatile("v_cvt_pk_bf16_f32 %0, %1, %2" : "=v"(r) : "v"(lo), "v"(hi)); return r; }

template <class Epi, class Sched, bool ALIGN_EPI, bool GATHER>
__device__ __forceinline__ void gemm_phase(LAS unsigned char* lds, const Gemm g, const Sched& S, const Epi& E, const LAS int* tokTab) {
    const int tid = threadIdx.x, wid = __builtin_amdgcn_readfirstlane(tid >> 6), lane = tid & 63, wr = wid >> 2, wc = wid & 3, fr = lane & 15, fq = lane >> 4;
    const int K = g.K, nt = K / BK;
    unsigned voffA[2], voffB[2];
#pragma unroll
    for (int i = 0; i < 2; ++i) { int R, C; stage_rc(tid * 16 + i * 8192, R, C); const int Rb = Epi::PERM ? ((R & ~31) + perm32(R & 31)) : R;
        voffA[i] = (unsigned)(R * K + C) * 2u; voffB[i] = (unsigned)(Rb * K + C) * 2u; }
    const size_t kstep = (size_t)(BK * 2);
    const size_t hstep = (size_t)HALF * K * 2;
    const size_t tstep = 2 * hstep;
    const unsigned ldsw = (unsigned)wid * 1024u;
    const int aoff = lds_byte(wr * 64 + fr, fq * 8), boff = lds_byte(wc * 32 + fr, fq * 8);
#define PG8_SA(b, h) (((b) * 2 + (h)) * HTB)
#define PG8_SB(b, h) ((4 + (b) * 2 + (h)) * HTB)
#define PG8_STAGE(bufoff, gbase, voff) do { _Pragma("unroll") for (int _i = 0; _i < 2; ++_i) \
        __builtin_amdgcn_global_load_lds((const unsigned*)((const char*)(gbase) + (voff)[_i]), (LAS unsigned*)(lds + (bufoff) + ldsw + _i * 8192), 16, 0, 0); } while (0)
#define PG8_STAGE_A(bufoff, kptr, h, vs) do { if constexpr (GATHER) { PG8_STAGE(bufoff, kptr, (vs)[h]); } else { PG8_STAGE(bufoff, (kptr) + (h) * hstep, voffA); } } while (0)
#define PG8_LDA(dst, b, h) do { _Pragma("unroll") for (int m = 0; m < 4; ++m) _Pragma("unroll") for (int k = 0; k < 2; ++k) dst[m][k] = *(const LAS bf16x8*)(lds + PG8_SA(b, h) + aoff + m * 2048 + k * 1024); } while (0)
#define PG8_LDB(dst, b, h) do { _Pragma("unroll") for (int n = 0; n < 2; ++n) _Pragma("unroll") for (int k = 0; k < 2; ++k) dst[n][k] = *(const LAS bf16x8*)(lds + PG8_SB(b, h) + boff + n * 2048 + k * 1024); } while (0)
#define PG8_MMA(ai, bj, At, Bt) do { __builtin_amdgcn_s_setprio(1); _Pragma("unroll") for (int m = 0; m < 4; ++m) _Pragma("unroll") for (int n = 0; n < 2; ++n) _Pragma("unroll") for (int k = 0; k < 2; ++k) \
        acc[ai][bj][m][n] = __builtin_amdgcn_mfma_f32_16x16x32_bf16(Bt[n][k], At[m][k], acc[ai][bj][m][n], 0, 0, 0); __builtin_amdgcn_s_setprio(0); } while (0)
#define PG8_WAIT_V(n) asm volatile("s_waitcnt vmcnt(" #n ")" ::: "memory")
#define PG8_WAIT_L(n) asm volatile("s_waitcnt lgkmcnt(" #n ")" ::: "memory")
#define PG8_BAR __builtin_amdgcn_s_barrier()
#define PG8_SCHED __builtin_amdgcn_sched_barrier(0)
#define PG8_GATHER_LOAD(vs, uo) do { _Pragma("unroll") for (int _i = 0; _i < 2; ++_i) { int _R, _C; stage_rc(tid * 16 + _i * 8192, _R, _C); _Pragma("unroll") for (int _h = 0; _h < 2; ++_h) \
        (vs)[_h][_i] = (unsigned)tokTab[(uo) * 256 + _h * 128 + _R] * (unsigned)(K * 2) + (unsigned)_C * 2u; } } while (0)
    Unit cur, nxt; int ui = 0;
    if (!S.next(0, cur)) return;
    f32x4 acc[2][2][4][2];
#pragma unroll
    for (int a = 0; a < 2; ++a)
#pragma unroll
        for (int b = 0; b < 2; ++b)
#pragma unroll
            for (int m = 0; m < 4; ++m)
#pragma unroll
                for (int n = 0; n < 2; ++n) acc[a][b][m][n] = (f32x4){0.f, 0.f, 0.f, 0.f};
    bf16x8 At[4][2], B0[2][2], B1[2][2];
    unsigned vC[2][2], v2[2][2];
    if constexpr (GATHER) { PG8_GATHER_LOAD(vC, 0); } else { vC[0][0] = vC[0][1] = vC[1][0] = vC[1][1] = 0u; }
    const char* cA = GATHER ? (const char*)g.A : (const char*)g.A + (size_t)cur.pm * tstep; const char* cB = (const char*)g.Bt + (size_t)cur.pn * tstep;
    PG8_STAGE(PG8_SB(0, 0), cB, voffB); PG8_STAGE(PG8_SB(0, 1), cB + hstep, voffB); PG8_STAGE_A(PG8_SA(0, 0), cA, 0, vC); PG8_STAGE_A(PG8_SA(0, 1), cA, 1, vC);
    if (wr == 1) PG8_BAR;
    PG8_WAIT_V(2); PG8_BAR;
    PG8_STAGE(PG8_SB(1, 0), cB + kstep, voffB); PG8_STAGE_A(PG8_SA(1, 0), cA + kstep, 0, vC); PG8_STAGE(PG8_SB(1, 1), cB + hstep + kstep, voffB);
    PG8_WAIT_V(6); PG8_BAR;
    for (;;) {
        const bool has_next = S.next(ui + 1, nxt);
        const char* nA = GATHER ? (const char*)g.A : (has_next ? (const char*)g.A + (size_t)nxt.pm * tstep : cA); const char* nB = has_next ? (const char*)g.Bt + (size_t)nxt.pn * tstep : cB;
        for (int t = 0; t < nt; t += 2) {
            const bool last = (t == nt - 2);
            const char* a1 = cA + (size_t)(t + 1) * kstep;
            const char* a2 = last ? nA : cA + (size_t)(t + 2) * kstep; const char* b2 = last ? nB : cB + (size_t)(t + 2) * kstep;
            const char* a3 = a2 + kstep; const char* b3 = b2 + kstep;
#pragma unroll
            for (int _h = 0; _h < 2; ++_h) { v2[_h][0] = vC[_h][0]; v2[_h][1] = vC[_h][1]; }
            if constexpr (GATHER) { if (last && has_next) { PG8_GATHER_LOAD(v2, ui + 1); } }
            PG8_LDB(B0, 0, 0); PG8_LDB(B1, 0, 1); PG8_SCHED; PG8_LDA(At, 0, 0); PG8_STAGE_A(PG8_SA(1, 1), a1, 1, vC);
            PG8_WAIT_V(8); PG8_WAIT_L(0); PG8_BAR; PG8_MMA(0, 0, At, B0); PG8_MMA(0, 1, At, B1); PG8_BAR; PG8_SCHED;
            PG8_LDA(At, 0, 1); PG8_STAGE(PG8_SB(0, 0), b2, voffB); PG8_STAGE(PG8_SB(0, 1), b2 + hstep, voffB); PG8_STAGE_A(PG8_SA(0, 0), a2, 0, v2);
            PG8_WAIT_V(8); PG8_WAIT_L(0); PG8_BAR; PG8_MMA(1, 0, At, B0); PG8_MMA(1, 1, At, B1); PG8_BAR; PG8_SCHED;
            PG8_LDB(B0, 1, 0); PG8_LDB(B1, 1, 1); PG8_SCHED; PG8_LDA(At, 1, 0); PG8_STAGE_A(PG8_SA(0, 1), a2, 1, v2);
            PG8_WAIT_V(8); PG8_WAIT_L(0); PG8_BAR; PG8_MMA(0, 0, At, B0); PG8_MMA(0, 1, At, B1); PG8_BAR; PG8_SCHED;
            PG8_LDA(At, 1, 1); PG8_STAGE(PG8_SB(1, 0), b3, voffB); PG8_STAGE(PG8_SB(1, 1), b3 + hstep, voffB); PG8_STAGE_A(PG8_SA(1, 0), a3, 0, v2);
            PG8_WAIT_V(8); PG8_WAIT_L(0); PG8_BAR; PG8_MMA(1, 0, At, B0); PG8_MMA(1, 1, At, B1); PG8_BAR; PG8_SCHED;
        }
        if constexpr (ALIGN_EPI) { if (wr == 0) PG8_BAR; }
        E(acc, cur, wr, wc, fr, fq);
        if (!has_next) break;
#pragma unroll
        for (int a = 0; a < 2; ++a)
#pragma unroll
            for (int b = 0; b < 2; ++b)
#pragma unroll
                for (int m = 0; m < 4; ++m)
#pragma unroll
                    for (int n = 0; n < 2; ++n) acc[a][b][m][n] = (f32x4){0.f, 0.f, 0.f, 0.f};
        cur = nxt; cA = nA; cB = nB; ++ui;
#pragma unroll
        for (int _h = 0; _h < 2; ++_h) { vC[_h][0] = v2[_h][0]; vC[_h][1] = v2[_h][1]; }
        if constexpr (ALIGN_EPI) { if (wr == 1) PG8_BAR; }
    }
    PG8_WAIT_V(0);
    if constexpr (!ALIGN_EPI) { if (wr == 0) PG8_BAR; }
    PG8_BAR;
#undef PG8_SA
#undef PG8_SB
#undef PG8_STAGE
#undef PG8_STAGE_A
#undef PG8_LDA
#undef PG8_LDB
#undef PG8_MMA
#undef PG8_WAIT_V
#undef PG8_WAIT_L
#undef PG8_BAR
#undef PG8_SCHED
#undef PG8_GATHER_LOAD
}

struct EpiProj {
    static constexpr bool PERM = true;
    bf16* O; const float* qg; const float* kg; const float* rope;
    __device__ __forceinline__ void operator()(const f32x4 (&acc)[2][2][4][2], const Unit& u, int wr, int wc, int fr, int fq) const {
        const int base = u.pn * BM + wc * 64;
        const bool isq = (base >= C_GQ) && (base < C_GK), isk = (base >= C_GK) && (base < C_GV);
        const float sc = (base < C_DK || isq) ? C2 : 1.f;
        if (isq || isk) {
            const float* g = isq ? qg : kg;
            f32x4 gv[2][2];
#pragma unroll
            for (int bj = 0; bj < 2; ++bj)
#pragma unroll
                for (int n = 0; n < 2; ++n) gv[bj][n] = *(const f32x4*)(g + 32 * bj + 8 * fq + 4 * n);
#pragma unroll
            for (int ai = 0; ai < 2; ++ai)
#pragma unroll
                for (int m = 0; m < 4; ++m) { const int t = u.pm * BM + ai * HALF + wr * 64 + m * 16 + fr; const int sp = t & (SEQ - 1); const int pr = sp >> 6, pcn = sp & 63;
                    float ss = 0.f;
#pragma unroll
                    for (int bj = 0; bj < 2; ++bj)
#pragma unroll
                        for (int n = 0; n < 2; ++n) { const f32x4 v = acc[ai][bj][m][n]; ss += (v[0] * v[0] + v[1] * v[1]) + (v[2] * v[2] + v[3] * v[3]); }
                    { auto s1 = __builtin_amdgcn_permlane16_swap(__float_as_uint(ss), __float_as_uint(ss), false, false); ss = __uint_as_float(s1[0]) + __uint_as_float(s1[1]);
                      auto s2 = __builtin_amdgcn_permlane32_swap(__float_as_uint(ss), __float_as_uint(ss), false, false); ss = __uint_as_float(s2[0]) + __uint_as_float(s2[1]); }
                    const float r = sc / sqrtf(ss * (1.f / 64.f) + RMS_EPS);
                    bf16* rowp = O + (size_t)t * INC + base + 8 * fq;
#pragma unroll
                    for (int bj = 0; bj < 2; ++bj) { const int pos = bj ? pcn : pr;
                        f32x4 o2[2];
#pragma unroll
                        for (int n = 0; n < 2; ++n) { const f32x4 y = acc[ai][bj][m][n] * gv[bj][n] * r;
                            const float c0 = rope[pos * 16 + 4 * fq + 2 * n], c1 = rope[pos * 16 + 4 * fq + 2 * n + 1], s0 = rope[1024 + pos * 16 + 4 * fq + 2 * n], s1 = rope[1024 + pos * 16 + 4 * fq + 2 * n + 1];
                            o2[n][0] = y[0] * c0 - y[1] * s0; o2[n][1] = y[0] * s0 + y[1] * c0; o2[n][2] = y[2] * c1 - y[3] * s1; o2[n][3] = y[2] * s1 + y[3] * c1; }
                        u32x4 w; w.x = cvt_pk_bf16(o2[0][0], o2[0][1]); w.y = cvt_pk_bf16(o2[0][2], o2[0][3]); w.z = cvt_pk_bf16(o2[1][0], o2[1][1]); w.w = cvt_pk_bf16(o2[1][2], o2[1][3]);
                        *(u32x4*)(rowp + bj * 32) = w; } }
        } else {
#pragma unroll
            for (int ai = 0; ai < 2; ++ai)
#pragma unroll
                for (int m = 0; m < 4; ++m) { bf16* rowp = O + (size_t)(u.pm * BM + ai * HALF + wr * 64 + m * 16 + fr) * INC + base + 8 * fq;
#pragma unroll
                    for (int bj = 0; bj < 2; ++bj) { const f32x4 v0 = acc[ai][bj][m][0] * sc, v1 = acc[ai][bj][m][1] * sc;
                        u32x4 w; w.x = cvt_pk_bf16(v0[0], v0[1]); w.y = cvt_pk_bf16(v0[2], v0[3]); w.z = cvt_pk_bf16(v1[0], v1[1]); w.w = cvt_pk_bf16(v1[2], v1[3]);
                        *(u32x4*)(rowp + bj * 32) = w; } }
        }
    }
};
struct EpiOut {
    static constexpr bool PERM = false;
    float* O; const float* X; const float* mod;
    __device__ __forceinline__ void operator()(const f32x4 (&acc)[2][2][4][2], const Unit& u, int wr, int wc, int fr, int fq) const {
        const int b = (u.pm * BM) / SEQ; const int col0 = u.pn * BM + wc * 32 + 4 * fq;
        f32x4 gv[2][2];
#pragma unroll
        for (int bj = 0; bj < 2; ++bj)
#pragma unroll
            for (int n = 0; n < 2; ++n) gv[bj][n] = *(const f32x4*)(mod + b * 6144 + 2048 + col0 + bj * HALF + n * 16) + 1.f;
#pragma unroll
        for (int ai = 0; ai < 2; ++ai)
#pragma unroll
            for (int m = 0; m < 4; ++m) { const size_t off = (size_t)(u.pm * BM + ai * HALF + wr * 64 + m * 16 + fr) * DM + col0;
#pragma unroll
                for (int bj = 0; bj < 2; ++bj)
#pragma unroll
                    for (int n = 0; n < 2; ++n) { const f32x4 xv = *(const f32x4*)(X + off + bj * HALF + n * 16);
                        *(f32x4*)(O + off + bj * HALF + n * 16) = xv * ALPHA + gv[bj][n] * acc[ai][bj][m][n]; } }
    }
};
struct EpiGateUp {
    static constexpr bool PERM = true;
    bf16* O;
    __device__ __forceinline__ void operator()(const f32x4 (&acc)[2][2][4][2], const Unit& u, int wr, int wc, int fr, int fq) const {
#pragma unroll
        for (int ai = 0; ai < 2; ++ai)
#pragma unroll
            for (int m = 0; m < 4; ++m) { bf16* rowp = O + (size_t)(u.pm * BM + ai * HALF + wr * 64 + m * 16 + fr) * DEXP + (u.pn & 3) * 128 + wc * 32 + 8 * fq;
                f32x4 h[2];
#pragma unroll
                for (int n = 0; n < 2; ++n)
#pragma unroll
                    for (int c = 0; c < 4; ++c) { const float gt = acc[ai][0][m][n][c], up = acc[ai][1][m][n][c]; h[n][c] = gt * __builtin_amdgcn_rcpf(1.f + __expf(-gt)) * up; }
                u32x4 w; w.x = cvt_pk_bf16(h[0][0], h[0][1]); w.y = cvt_pk_bf16(h[0][2], h[0][3]); w.z = cvt_pk_bf16(h[1][0], h[1][1]); w.w = cvt_pk_bf16(h[1][2], h[1][3]);
                *(u32x4*)rowp = w; }
    }
};
struct EpiDown {
    static constexpr bool PERM = true;
    bf16* O;
    __device__ __forceinline__ void operator()(const f32x4 (&acc)[2][2][4][2], const Unit& u, int wr, int wc, int fr, int fq) const {
#pragma unroll
        for (int ai = 0; ai < 2; ++ai)
#pragma unroll
            for (int m = 0; m < 4; ++m) { bf16* rowp = O + (size_t)(u.pm * BM + ai * HALF + wr * 64 + m * 16 + fr) * DM + (u.pn & 3) * BM + wc * 32 + 8 * fq;
#pragma unroll
                for (int bj = 0; bj < 2; ++bj) { const f32x4 v0 = acc[ai][bj][m][0], v1 = acc[ai][bj][m][1];
                    u32x4 w; w.x = cvt_pk_bf16(v0[0], v0[1]); w.y = cvt_pk_bf16(v0[2], v0[3]); w.z = cvt_pk_bf16(v1[0], v1[1]); w.w = cvt_pk_bf16(v1[2], v1[3]);
                    *(u32x4*)(rowp + bj * HALF) = w; } }
    }
};
struct ExpertOrder {
    const LAS int* toff; int G, v;
    __device__ __forceinline__ bool next(int i, Unit& u) const {
        const int L = i * G + v; const int ntile = toff[32];
        if (L >= ntile * 4) return false;
        const int tile = L >> 2; int e = 0;
        for (int k = 1; k < NEXP; ++k) if (toff[k] <= tile) e = k;
        u.pm = tile; u.pn = e * 4 + (L & 3); return true;
    }
};
}


namespace attn {
using bf16=__hip_bfloat16;
using bf16x8=__attribute__((ext_vector_type(8)))short;
using s16x4=__attribute__((ext_vector_type(4)))short;
using f32x16=__attribute__((ext_vector_type(16)))float;
using u32x4=__attribute__((ext_vector_type(4)))unsigned;
constexpr int NW=8,QBLK=32,QB=QBLK*NW,KVBLK=64,SEQK=2048,PITCH=2304,OPITCH=1024;
__device__ __forceinline__ int crow(int r,int hi){return (r&3)+8*(r>>2)+4*hi;}
#define SBAR() __builtin_amdgcn_sched_barrier(0)

constexpr int NSLOT=3, SLOTB=8192;
constexpr int LDS_K=0, LDS_V=NSLOT*SLOTB, LDS_WS=2*NSLOT*SLOTB, LDS_OST=LDS_WS+NW*64*4, LDS_TB=LDS_OST+NW*4096, LDS_BYTES=LDS_TB+2048;
__device__ __forceinline__ void glds16(const void*gsrc,unsigned lds_dst){unsigned keep;
  asm volatile("s_mov_b32 %0, m0\n\ts_mov_b32 m0, %2\n\ts_nop 0\n\tglobal_load_lds_dwordx4 %1, off\n\ts_mov_b32 m0, %0":"=&s"(keep):"v"(gsrc),"s"(lds_dst):"memory");}
__device__ __forceinline__ float max3f(float a,float b,float c){float r;asm("v_max3_f32 %0, %1, %2, %3":"=v"(r):"v"(a),"v"(b),"v"(c));return r;}
__device__ __forceinline__ float max2f(float a,float b){float r;asm("v_max_f32_e32 %0, %1, %2":"=v"(r):"v"(a),"v"(b));return r;}
__device__ __forceinline__ float fadd_s(float a,float b){float r;asm("v_add_f32_e32 %0, %1, %2":"=v"(r):"v"(a),"v"(b));return r;}
__device__ __forceinline__ float fsub_s(float a,float b){float r;asm("v_sub_f32_e32 %0, %1, %2":"=v"(r):"v"(a),"v"(b));return r;}
typedef float f32x2_t __attribute__((ext_vector_type(2))); typedef __bf16 bf16x2_t __attribute__((ext_vector_type(2)));
__device__ __forceinline__ unsigned cvtpk_s(float lo,float hi){f32x2_t v={lo,hi};bf16x2_t b=__builtin_convertvector(v,bf16x2_t);return __builtin_bit_cast(unsigned,b);}
#define WAIT_BAR(N) asm volatile("s_waitcnt vmcnt(" #N ") lgkmcnt(0)\n\ts_barrier":::"memory")

__device__ __forceinline__ void qkt(f32x16&p0,f32x16&p1,const char*Kslot,const bf16x8*qr,const f32x16&ci0,const f32x16&ci1,int r32,int hi){
  const char*kb=Kslot+hi*1024+r32*16;
  #pragma unroll
  for(int d0=0;d0<4;++d0){
    const bf16x8 b0=*reinterpret_cast<const bf16x8*>(kb+d0*2048);
    const bf16x8 b1=*reinterpret_cast<const bf16x8*>(kb+d0*2048+512);
    if(d0==0){p0=__builtin_amdgcn_mfma_f32_32x32x16_bf16(b0,qr[0],ci0,0,0,0);p1=__builtin_amdgcn_mfma_f32_32x32x16_bf16(b1,qr[0],ci1,0,0,0);}
    else{p0=__builtin_amdgcn_mfma_f32_32x32x16_bf16(b0,qr[d0],p0,0,0,0);p1=__builtin_amdgcn_mfma_f32_32x32x16_bf16(b1,qr[d0],p1,0,0,0);}}
}
typedef __attribute__((address_space(3))) const char* lds_cptr;
typedef short v4i16_t __attribute__((ext_vector_type(4)));
__device__ __forceinline__ void kload8(bf16x8*kf,lds_cptr kp){
  kf[0]=*(const __attribute__((address_space(3))) bf16x8*)(kp);      kf[1]=*(const __attribute__((address_space(3))) bf16x8*)(kp+512);
  kf[2]=*(const __attribute__((address_space(3))) bf16x8*)(kp+2048); kf[3]=*(const __attribute__((address_space(3))) bf16x8*)(kp+2560);
  kf[4]=*(const __attribute__((address_space(3))) bf16x8*)(kp+4096); kf[5]=*(const __attribute__((address_space(3))) bf16x8*)(kp+4608);
  kf[6]=*(const __attribute__((address_space(3))) bf16x8*)(kp+6144); kf[7]=*(const __attribute__((address_space(3))) bf16x8*)(kp+6656);
}
__device__ __forceinline__ void kload2(bf16x8*kf,lds_cptr kp,int j){ kf[2*j]=*(const __attribute__((address_space(3))) bf16x8*)(kp+j*2048); kf[2*j+1]=*(const __attribute__((address_space(3))) bf16x8*)(kp+j*2048+512); }
__device__ __forceinline__ s16x4 vtr(lds_cptr p){ return __builtin_bit_cast(s16x4,__builtin_amdgcn_ds_read_tr16_b64_v4i16((__attribute__((address_space(3))) v4i16_t*)p)); }
__device__ __forceinline__ float rowmax(const f32x16&p0,const f32x16&p1){
  float a=max3f(p0[0],p0[1],p1[0]),b=max3f(p0[2],p0[3],p1[1]);a=max3f(a,p1[2],p1[3]);
  #pragma unroll
  for(int r=4;r<16;r+=4){a=max3f(a,p0[r],p0[r+1]);b=max3f(b,p0[r+2],p0[r+3]);a=max3f(a,p1[r],p1[r+1]);b=max3f(b,p1[r+2],p1[r+3]);}
  const float m=max2f(a,b);
  auto rr=__builtin_amdgcn_permlane32_swap(__float_as_uint(m),__float_as_uint(m),false,false);
  return max2f(__uint_as_float(rr[0]),__uint_as_float(rr[1]));
}
__device__ __forceinline__ void pv(f32x16*o,int vb,bf16x8 pa0,bf16x8 pa1,bf16x8 pa2,bf16x8 pa3){
  #pragma unroll
  for(int d0=0;d0<2;++d0){s16x4 lo[4],hi[4];
    #pragma unroll
    for(int ks=0;ks<4;++ks){
      asm volatile("ds_read_b64_tr_b16 %0,%1 offset:%c2":"=&v"(lo[ks]):"v"(vb),"i"(d0*4096+ks*1024):"memory");
      asm volatile("ds_read_b64_tr_b16 %0,%1 offset:%c2":"=&v"(hi[ks]):"v"(vb),"i"(d0*4096+ks*1024+512):"memory");}
    asm volatile("s_waitcnt lgkmcnt(0)":::"memory");SBAR();
    #define PK(k) (bf16x8){lo[k][0],lo[k][1],lo[k][2],lo[k][3],hi[k][0],hi[k][1],hi[k][2],hi[k][3]}
    o[d0]=__builtin_amdgcn_mfma_f32_32x32x16_bf16(pa0,PK(0),o[d0],0,0,0);
    o[d0]=__builtin_amdgcn_mfma_f32_32x32x16_bf16(pa1,PK(1),o[d0],0,0,0);
    o[d0]=__builtin_amdgcn_mfma_f32_32x32x16_bf16(pa2,PK(2),o[d0],0,0,0);
    o[d0]=__builtin_amdgcn_mfma_f32_32x32x16_bf16(pa3,PK(3),o[d0],0,0,0);
    #undef PK
  }
}

template<int THRL,bool BIAS> __device__ __forceinline__ void attn_run(const bf16*Qb,const bf16*__restrict__ Kh,const bf16*__restrict__ Vh,bf16*Ob,float*Sw,int scol,float lam,float dlt,int qpos0,char*shm){
  int tid_=threadIdx.x; asm volatile("":"+v"(tid_));
  const int tid=tid_,lane=tid&63,r32=lane&31,hi=lane>>5; const int wid=__builtin_amdgcn_readfirstlane(tid>>6);
  const bf16*Qw=Qb+(long)(wid*QBLK)*PITCH;
  const unsigned lds0=(unsigned)(uintptr_t)shm;
  float*wsf=(float*)(shm+LDS_WS)+wid*64;
  const bf16*ksrc=Kh+(long)lane*PITCH+wid*8;
  const bf16*vsrc=Vh+(long)(16*(wid&3)+(lane>>2))*PITCH+(wid>>2)*32+(lane&3)*8;
  const unsigned kdst=lds0+LDS_K+wid*1024, vdst=lds0+LDS_V+wid*1024;
  #define DMA_K(t,slot) glds16(ksrc+(long)(t)*KVBLK*PITCH,(unsigned)__builtin_amdgcn_readfirstlane(kdst+(slot)))
  #define DMA_V(t,slot) glds16(vsrc+(long)(t)*KVBLK*PITCH,(unsigned)__builtin_amdgcn_readfirstlane(vdst+(slot)))
  const int vb0=(int)(lds0+LDS_V)+((lane>>4)&1)*32+(lane&3)*8+(4*hi+((lane&15)>>2))*64;
  const char*Kbase=shm+LDS_K; bf16x8 kf[8];
  const lds_cptr shm3=(lds_cptr)shm; const lds_cptr kp0=shm3+LDS_K+hi*1024+r32*16; const lds_cptr vp0=shm3+LDS_V+((lane>>4)&1)*32+(lane&3)*8+(4*hi+((lane&15)>>2))*64;
  constexpr int NT=SEQK/KVBLK;
  DMA_K(0,0);DMA_V(0,0);DMA_K(1,SLOTB);
  bf16x8 qr[4];
  #pragma unroll
  for(int d0=0;d0<4;++d0)qr[d0]=*reinterpret_cast<const bf16x8*>(&Qw[(long)r32*PITCH+d0*16+hi*8]);
  float mhat=0.f,l_reg=0.f;f32x16 o[2];o[0]=f32x16{};o[1]=f32x16{};f32x16 negm=f32x16{};asm volatile("":"+v"(negm));
  float pc=0.f;
  const int qw0=qpos0+wid*QBLK;
  const int tL=BIAS?((qw0>=154)?((qw0-154)/64+1):0):NT, tR=BIAS?((qw0+122+63)/64):NT;
  const lds_cptr tbp=(lds_cptr)shm+LDS_TB+4*(256-qw0+4*hi-r32);
  #define BIASADD(C0,C1,t) do{ if(BIAS&&(t)>=tL&&(t)<tR){ const lds_cptr tp_=tbp+256*(t); _Pragma("unroll") for(int r=0;r<16;++r){ \
      C0[r]+=*(const __attribute__((address_space(3))) float*)(tp_+4*((r&3)+8*(r>>2))); C1[r]+=*(const __attribute__((address_space(3))) float*)(tp_+4*((r&3)+8*(r>>2)+32)); } } }while(0)
  #define SETPC(t) do{ if(BIAS&&(t)==tR){ pc=dlt; _Pragma("unroll") for(int r=0;r<16;++r)negm[r]=pc-mhat; asm volatile("":"+v"(negm)); } }while(0)
  #define CMASK(P0,P1,t) BIASADD(P0,P1,t)
  bool resc=false;
  #define START(P0,P1) do{ const float rm=rowmax(P0,P1); resc=false; \
    { const float dl=rm; mhat=fadd_s(mhat,dl); \
      _Pragma("unroll") for(int r=0;r<16;++r){P0[r]=fsub_s(P0[r],dl);P1[r]=fsub_s(P1[r],dl);} \
      _Pragma("unroll") for(int r=0;r<16;++r)negm[r]=pc-mhat; asm volatile("":"+v"(negm)); } \
    _Pragma("unroll") for(int r=0;r<16;++r)P0[r]=__builtin_amdgcn_exp2f(P0[r]); }while(0)
  #define RESC() do{ if(resc){ asm volatile("s_waitcnt lgkmcnt(0)":::"memory"); \
      _Pragma("unroll") for(int d_=0;d_<2;++d_) _Pragma("unroll") for(int r=0;r<16;++r)o[d_][r]*=wsf[crow(r,hi)]; } }while(0)
  f32x16 pA0,pA1,pB0,pB1;
  int sl_prev=0,sl_cur=0,sl_next=SLOTB;
  #define ROT() do{sl_prev=sl_cur;sl_cur=sl_next;sl_next=(sl_next==(NSLOT-1)*SLOTB)?0:sl_next+SLOTB;}while(0)
  DMA_K(2,2*SLOTB);
  WAIT_BAR(3);
  SETPC(0);
  qkt(pA0,pA1,Kbase,qr,negm,negm,r32,hi);asm volatile("s_nop 15\n\ts_nop 7":"+v"(pA0),"+v"(pA1));CMASK(pA0,pA1,0);
  START(pA0,pA1);
  _Pragma("unroll") for(int r=0;r<16;++r)pA1[r]=__builtin_amdgcn_exp2f(pA1[r]);
  WAIT_BAR(0);
  DMA_K(3,0);DMA_V(1,SLOTB);
  ROT();
  kload8(kf,kp0+sl_cur);
  WAIT_BAR(2);
  s16x4 vlo[8],vhi[8]; u32x4 pw0,pw1,pw2,pw3;
  #define PKW(P,B) cvtpk_s(P[B],P[B+1])
  #define PAF(k) __builtin_bit_cast(bf16x8,pw##k)
  #define VFR(i) (bf16x8){vlo[i][0],vlo[i][1],vlo[i][2],vlo[i][3],vhi[i][0],vhi[i][1],vhi[i][2],vhi[i][3]}
  #define PIN(x) asm volatile("":"+v"(x))
  #define MX3(a,b,c) __builtin_fmaxf(__builtin_fmaxf((a),(b)),(c))
  #define GAPA(MF,A0,A1,A2,A3,W0,W1,PW) do{ MF; sacc+=A0; sacc+=A1; sacc+=A2; sacc+=A3; PIN(sacc); W0; W1; PIN(PW); SBAR(); }while(0)
  #define EX(v) __builtin_amdgcn_exp2f(v)
  #define GAPB(MF,X,B) do{ MF; X[B]=EX(X[B]); X[B+1]=EX(X[B+1]); X[B+2]=EX(X[B+2]); X[B+3]=EX(X[B+3]); PIN(X); SBAR(); }while(0)
  #define VRD(i) do{ vlo[i]=vtr(vp_+(((i)>>2)*4096+((i)&3)*1024)); vhi[i]=vtr(vp_+(((i)>>2)*4096+((i)&3)*1024+512)); }while(0)
  #define KRD(G,j) do{ if(G){ kload2(kf,kp0+sl_next,j); SBAR(); } }while(0)
  #define STEP(C0,C1,P0,P1,t,GK,GV,GL) do{ SETPC(t); SBAR(); \
    const lds_cptr vp_=vp0+sl_prev; \
    VRD(0); SBAR(); float sacc=(P0[0]+P0[1]); \
    GAPA(C0=__builtin_amdgcn_mfma_f32_32x32x16_bf16(kf[0],qr[0],negm,0,0,0), P0[2],P0[3],P0[4],P0[5],     pw0[0]=PKW(P0,0), pw0[1]=PKW(P0,2), pw0); \
    VRD(4); SBAR(); GAPA(C1=__builtin_amdgcn_mfma_f32_32x32x16_bf16(kf[1],qr[0],negm,0,0,0), P0[6],P0[7],P0[8],P0[9],     pw0[2]=PKW(P0,4), pw0[3]=PKW(P0,6), pw0); \
    VRD(1); SBAR(); GAPA(C0=__builtin_amdgcn_mfma_f32_32x32x16_bf16(kf[2],qr[1],C0,0,0,0),   P0[10],P0[11],P0[12],P0[13], pw1[0]=PKW(P0,8), pw1[1]=PKW(P0,10), pw1); \
    VRD(5); SBAR(); GAPA(C1=__builtin_amdgcn_mfma_f32_32x32x16_bf16(kf[3],qr[1],C1,0,0,0),   P0[14],P0[15],P1[0],P1[1],   pw1[2]=PKW(P0,12),pw1[3]=PKW(P0,14), pw1); \
    VRD(2); SBAR(); GAPA(C0=__builtin_amdgcn_mfma_f32_32x32x16_bf16(kf[4],qr[2],C0,0,0,0),   P1[2],P1[3],P1[4],P1[5],     pw2[0]=PKW(P1,0), pw2[1]=PKW(P1,2), pw2); \
    VRD(6); SBAR(); GAPA(C1=__builtin_amdgcn_mfma_f32_32x32x16_bf16(kf[5],qr[2],C1,0,0,0),   P1[6],P1[7],P1[8],P1[9],     pw2[2]=PKW(P1,4), pw2[3]=PKW(P1,6), pw2); \
    VRD(3); SBAR(); GAPA(C0=__builtin_amdgcn_mfma_f32_32x32x16_bf16(kf[6],qr[3],C0,0,0,0),   P1[10],P1[11],P1[12],P1[13], pw3[0]=PKW(P1,8), pw3[1]=PKW(P1,10), pw3); \
    VRD(7); SBAR(); GAPA(C1=__builtin_amdgcn_mfma_f32_32x32x16_bf16(kf[7],qr[3],C1,0,0,0),   P1[14],P1[15],0.f,0.f,       pw3[2]=PKW(P1,12),pw3[3]=PKW(P1,14), pw3); \
    l_reg+=sacc; \
    if(GK){DMA_K((t)+3,sl_cur);} if(GV){DMA_V((t)+1,sl_next);} \
    CMASK(C0,C1,t); \
    { float a=MX3(C0[0],C0[1],C1[0]),b=MX3(C0[2],C0[3],C1[1]); a=MX3(a,C1[2],C1[3]); \
      _Pragma("unroll") for(int r=4;r<16;r+=4){a=MX3(a,C0[r],C0[r+1]);b=MX3(b,C0[r+2],C0[r+3]);a=MX3(a,C1[r],C1[r+1]);b=MX3(b,C1[r+2],C1[r+3]);} \
      float rm=__builtin_fmaxf(a,b); { auto rr=__builtin_amdgcn_permlane32_swap(__float_as_uint(rm),__float_as_uint(rm),false,false); rm=__builtin_fmaxf(__uint_as_float(rr[0]),__uint_as_float(rr[1])); } \
      resc=false; \
      if(__builtin_expect(__any(rm>(float)THRL),0)){ const float dl=__builtin_fmaxf(rm,0.f); mhat+=dl; \
        _Pragma("unroll") for(int r=0;r<16;++r){C0[r]-=dl;C1[r]-=dl;} \
        _Pragma("unroll") for(int r=0;r<16;++r)negm[r]=pc-mhat; asm volatile("":"+v"(negm)); \
        const float f=__builtin_amdgcn_exp2f(-dl); l_reg*=f; if(hi==0)wsf[r32]=f; resc=true; } } \
    SBAR(); \
    GAPB(o[0]=__builtin_amdgcn_mfma_f32_32x32x16_bf16(PAF(0),VFR(0),o[0],0,0,0), C0,0); \
    GAPB(o[1]=__builtin_amdgcn_mfma_f32_32x32x16_bf16(PAF(0),VFR(4),o[1],0,0,0), C0,4); \
    KRD(GL,0); GAPB(o[0]=__builtin_amdgcn_mfma_f32_32x32x16_bf16(PAF(1),VFR(1),o[0],0,0,0), C0,8); \
    KRD(GL,1); GAPB(o[1]=__builtin_amdgcn_mfma_f32_32x32x16_bf16(PAF(1),VFR(5),o[1],0,0,0), C0,12); \
    KRD(GL,2); GAPB(o[0]=__builtin_amdgcn_mfma_f32_32x32x16_bf16(PAF(2),VFR(2),o[0],0,0,0), C1,0); \
    KRD(GL,3); GAPB(o[1]=__builtin_amdgcn_mfma_f32_32x32x16_bf16(PAF(2),VFR(6),o[1],0,0,0), C1,4); \
    GAPB(o[0]=__builtin_amdgcn_mfma_f32_32x32x16_bf16(PAF(3),VFR(3),o[0],0,0,0), C1,8); \
    GAPB(o[1]=__builtin_amdgcn_mfma_f32_32x32x16_bf16(PAF(3),VFR(7),o[1],0,0,0), C1,12); \
    }while(0)
  int t=1;
  for(;t+5<NT;t+=2){
    STEP(pB0,pB1,pA0,pA1,t,true,true,true);     WAIT_BAR(2); RESC(); ROT();
    STEP(pA0,pA1,pB0,pB1,t+1,true,true,true);   WAIT_BAR(2); RESC(); ROT();
  }
  #define ENDW(tt) do{ if((tt)+3<NT){WAIT_BAR(2);} else if((tt)+2<NT){WAIT_BAR(1);} else {WAIT_BAR(0);} }while(0)
  for(;t+1<NT;t+=2){
    STEP(pB0,pB1,pA0,pA1,t,(t+3<NT),(t+1<NT),(t+1<NT));       ENDW(t);   RESC(); ROT();
    STEP(pA0,pA1,pB0,pB1,t+1,(t+4<NT),(t+2<NT),(t+2<NT));     ENDW(t+1); RESC(); ROT();
  }
  STEP(pB0,pB1,pA0,pA1,NT-1,false,false,false); RESC();
  { float sacc=pB0[0]+pB0[1]; _Pragma("unroll") for(int r=2;r<16;++r)sacc+=pB0[r]; _Pragma("unroll") for(int r=0;r<16;++r)sacc+=pB1[r]; l_reg+=sacc;
    pw0=(u32x4){PKW(pB0,0),PKW(pB0,2),PKW(pB0,4),PKW(pB0,6)};pw1=(u32x4){PKW(pB0,8),PKW(pB0,10),PKW(pB0,12),PKW(pB0,14)};pw2=(u32x4){PKW(pB1,0),PKW(pB1,2),PKW(pB1,4),PKW(pB1,6)};pw3=(u32x4){PKW(pB1,8),PKW(pB1,10),PKW(pB1,12),PKW(pB1,14)};
    SBAR(); pv(o,vb0+sl_cur,PAF(0),PAF(1),PAF(2),PAF(3)); }
  #undef PKW
  #undef PAF
  #undef VFR
  #undef PIN
  #undef MX3
  #undef GAPA
  #undef GAPB
  #undef EX
  #undef VRD
  #undef KRD
  #undef STEP
  #undef BIASADD
  #undef SETPC
  #undef ENDW
  {auto rr=__builtin_amdgcn_permlane32_swap(__float_as_uint(l_reg),__float_as_uint(l_reg),false,false);l_reg=__uint_as_float(rr[0])+__uint_as_float(rr[1]);}
  if(hi==0)wsf[32+r32]=l_reg;asm volatile("s_waitcnt lgkmcnt(0)":::"memory");
  float rli[16];
  #pragma unroll
  for(int r=0;r<16;++r)rli[r]=__builtin_amdgcn_rcpf(wsf[32+crow(r,hi)]);
  if constexpr(!BIAS){ bf16*Ow=Ob+(long)(wid*QBLK)*OPITCH;
    bf16*stg=(bf16*)(shm+LDS_OST)+wid*2048;
    #pragma unroll
    for(int r=0;r<16;++r){const int orow=crow(r,hi);
      #pragma unroll
      for(int d0=0;d0<2;++d0)stg[orow*64+d0*32+r32]=__float2bfloat16(o[d0][r]*rli[r]);}
    asm volatile("s_waitcnt lgkmcnt(0)":::"memory");
    #pragma unroll
    for(int i=0;i<4;++i){const int row=i*8+(lane>>3),ch=lane&7; const u32x4 v=*(const u32x4*)(stg+row*64+ch*8); *(u32x4*)(Ow+(long)row*OPITCH+ch*8)=v;} }
  else { float*Sp=Sw+scol+r32;
    #pragma unroll
    for(int r=0;r<16;++r){const int orow=crow(r,hi);
      #pragma unroll
      for(int d0=0;d0<2;++d0){ float*p=Sp+orow*128+d0*32; const float v=o[d0][r]*rli[r]; if(lam==0.f)*p=v; else *p=*p-lam*v; } } }
  asm volatile("s_waitcnt lgkmcnt(0)\n\ts_barrier":::"memory");
  #undef DMA_K
  #undef DMA_V
  #undef CMASK
  #undef START
  #undef RESC
  #undef ROT
}

constexpr int L8_K=0, L8_V=NSLOT*SLOTB, SLOTV=16384, L8_WS=L8_V+NSLOT*SLOTV, L8_TB=L8_WS+NW*64*4, L8_Q=L8_TB+2048, L8_BYTES=L8_Q+NW*4096;
template<int THRL> __device__ __forceinline__ void attn_run128(const bf16*Qb,const bf16*__restrict__ Kh,const bf16*__restrict__ Vh,float*Sw,float lam,float dlt,int qpos0,char*shm){
  int tid_=threadIdx.x; asm volatile("":"+v"(tid_));
  const int tid=tid_,lane=tid&63,r32=lane&31,hi=lane>>5; const int wid=__builtin_amdgcn_readfirstlane(tid>>6);
  const bf16*Qw=Qb+(long)(wid*QBLK)*PITCH;
  const unsigned lds0=(unsigned)(uintptr_t)shm;
  float*wsf=(float*)(shm+L8_WS)+wid*64;
  const bf16*ksrc=Kh+(long)lane*PITCH+wid*8;
  const bf16*vsrc=Vh+(long)(16*(wid&3)+(lane>>2))*PITCH+(wid>>2)*32+(lane&3)*8;
  const unsigned kdst=lds0+L8_K+wid*1024, vdst=lds0+L8_V+wid*1024;
  #define DMA_K(t,slot) glds16(ksrc+(long)(t)*KVBLK*PITCH,(unsigned)__builtin_amdgcn_readfirstlane(kdst+(slot)))
  #define DMA_V(t,slot) do{ glds16(vsrc+(long)(t)*KVBLK*PITCH,(unsigned)__builtin_amdgcn_readfirstlane(vdst+2*(slot))); glds16(vsrc+(long)(t)*KVBLK*PITCH+64,(unsigned)__builtin_amdgcn_readfirstlane(vdst+2*(slot)+8192)); }while(0)
  const char*Kbase=shm+L8_K; bf16x8 kf[8];
  const lds_cptr shm3=(lds_cptr)shm; const lds_cptr kp0=shm3+L8_K+hi*1024+r32*16; const lds_cptr vp0=shm3+L8_V+((lane>>4)&1)*32+(lane&3)*8+(4*hi+((lane&15)>>2))*64;
  constexpr int NT=SEQK/KVBLK;
  DMA_K(0,0);DMA_V(0,0);DMA_K(1,SLOTB);
  bf16x8 qr[4];
  #pragma unroll
  for(int d0=0;d0<4;++d0)qr[d0]=*reinterpret_cast<const bf16x8*>(&Qw[(long)r32*PITCH+d0*16+hi*8]);
  const lds_cptr qp=(lds_cptr)shm+L8_Q+wid*4096+lane*16;
  #pragma unroll
  for(int d0=1;d0<4;++d0)*(__attribute__((address_space(3))) bf16x8*)(qp+d0*1024)=qr[d0];
  float mhat=0.f,l_reg=0.f;f32x16 o[4];o[0]=f32x16{};o[1]=f32x16{};o[2]=f32x16{};o[3]=f32x16{};float nm=0.f;
  float pc=0.f;
  const int qw0=qpos0+wid*QBLK;
  const int tL=(qw0>=154)?((qw0-154)/64+1):0, tR=(qw0+122+63)/64;
  const lds_cptr tbp=(lds_cptr)shm+L8_TB+4*(256-qw0+4*hi-r32);
  #define BIASADD(C0,C1,t) do{ if((t)>=tL&&(t)<tR){ const lds_cptr tp_=tbp+256*(t); _Pragma("unroll") for(int r=0;r<16;++r){ \
      C0[r]+=*(const __attribute__((address_space(3))) float*)(tp_+4*((r&3)+8*(r>>2))); C1[r]+=*(const __attribute__((address_space(3))) float*)(tp_+4*((r&3)+8*(r>>2)+32)); } } }while(0)
  #define SETPC(t) do{ if((t)==tR){ pc=dlt; nm=pc-mhat; } }while(0)
  bool resc=false;
  #define RESC() do{ if(resc){ asm volatile("s_waitcnt lgkmcnt(0)":::"memory"); \
      _Pragma("unroll") for(int d_=0;d_<4;++d_) _Pragma("unroll") for(int r=0;r<16;++r)o[d_][r]*=wsf[crow(r,hi)]; } }while(0)
  f32x16 c0,c1;
  int sl_prev=0,sl_cur=0,sl_next=SLOTB;
  #define ROT() do{sl_prev=sl_cur;sl_cur=sl_next;sl_next=(sl_next==(NSLOT-1)*SLOTB)?0:sl_next+SLOTB;}while(0)
  DMA_K(2,2*SLOTB);
  WAIT_BAR(4);
  u32x4 pa0,pa1,pa2,pa3,pb0,pb1,pb2,pb3;
  #define PKW(P,B) cvtpk_s(P[B],P[B+1])
  SETPC(0);
  { const f32x16 z=f32x16{}; qkt(c0,c1,Kbase,qr,z,z,r32,hi); } asm volatile("s_nop 15\n\ts_nop 7":"+v"(c0),"+v"(c1));BIASADD(c0,c1,0);
  { const float rm=rowmax(c0,c1); mhat=fadd_s(mhat,rm);
    _Pragma("unroll") for(int r=0;r<16;++r){c0[r]=fsub_s(c0[r],rm);c1[r]=fsub_s(c1[r],rm);}
    nm=pc-mhat;
    _Pragma("unroll") for(int r=0;r<16;++r){c0[r]=__builtin_amdgcn_exp2f(c0[r]);c1[r]=__builtin_amdgcn_exp2f(c1[r]);}
    float sacc=c0[0]+c0[1]; _Pragma("unroll") for(int r=2;r<16;++r)sacc+=c0[r]; _Pragma("unroll") for(int r=0;r<16;++r)sacc+=c1[r]; l_reg+=sacc;
    pa0=(u32x4){PKW(c0,0),PKW(c0,2),PKW(c0,4),PKW(c0,6)};pa1=(u32x4){PKW(c0,8),PKW(c0,10),PKW(c0,12),PKW(c0,14)};pa2=(u32x4){PKW(c1,0),PKW(c1,2),PKW(c1,4),PKW(c1,6)};pa3=(u32x4){PKW(c1,8),PKW(c1,10),PKW(c1,12),PKW(c1,14)}; }
  WAIT_BAR(0);
  DMA_K(3,0);DMA_V(1,SLOTB);
  ROT();
  kload8(kf,kp0+sl_cur);
  WAIT_BAR(3);
  s16x4 vlo[4],vhi[4];
  #define PAFX(pw) __builtin_bit_cast(bf16x8,pw)
  #define VFR(i) (bf16x8){vlo[i][0],vlo[i][1],vlo[i][2],vlo[i][3],vhi[i][0],vhi[i][1],vhi[i][2],vhi[i][3]}
  #define PIN(x) asm volatile("":"+v"(x))
  #define MX3(a,b,c) __builtin_fmaxf(__builtin_fmaxf((a),(b)),(c))
  #define EX(v) __builtin_amdgcn_exp2f(v)
  #define VRDW(w,j) do{ vlo[w]=vtr(vp_+(((j)&3)*4096+((j)>>2)*1024)); vhi[w]=vtr(vp_+(((j)&3)*4096+((j)>>2)*1024+512)); }while(0)
  #define GAPA0(MF) do{ MF; SBAR(); }while(0)
  #define QLD(d0) (*(const __attribute__((address_space(3))) bf16x8*)(qp+(d0)*1024))
  #define GAPA8(MF,w,j) do{ VRDW(w,j); SBAR(); MF; SBAR(); }while(0)
  #define KRD(G,jj) do{ if(G){ kload2(kf,kp0+sl_next,jj); } }while(0)
  #define EXP2(C,b) do{ C[b]=EX(C[b]); C[b+1]=EX(C[b+1]); PIN(C); }while(0)
  #define SUMPK(C,b,PW,s) do{ sacc+=C[b]; sacc+=C[b+1]; PIN(sacc); PW[s]=PKW(C,b); PIN(PW); }while(0)
  #define STEP8(t,GK,GV,GL,PO0,PO1,PO2,PO3,PN0,PN1,PN2,PN3) do{ SETPC(t); SBAR(); \
    const lds_cptr vp_=vp0+2*sl_prev; float sacc=0.f; f32x16 cin_; _Pragma("unroll") for(int r=0;r<16;++r)cin_[r]=nm; PIN(cin_); \
    bf16x8 qa_=QLD(1),qb_; SBAR(); \
    GAPA0(c0=__builtin_amdgcn_mfma_f32_32x32x16_bf16(kf[0],qr[0],cin_,0,0,0)); \
    qb_=QLD(2); SBAR(); \
    GAPA0(c1=__builtin_amdgcn_mfma_f32_32x32x16_bf16(kf[1],qr[0],cin_,0,0,0)); \
    GAPA0(c0=__builtin_amdgcn_mfma_f32_32x32x16_bf16(kf[2],qa_,c0,0,0,0)); \
    GAPA0(c1=__builtin_amdgcn_mfma_f32_32x32x16_bf16(kf[3],qa_,c1,0,0,0)); \
    qa_=QLD(3); \
    GAPA8(c0=__builtin_amdgcn_mfma_f32_32x32x16_bf16(kf[4],qb_,c0,0,0,0),0,0); \
    GAPA8(c1=__builtin_amdgcn_mfma_f32_32x32x16_bf16(kf[5],qb_,c1,0,0,0),1,1); \
    GAPA8(c0=__builtin_amdgcn_mfma_f32_32x32x16_bf16(kf[6],qa_,c0,0,0,0),2,2); \
    GAPA8(c1=__builtin_amdgcn_mfma_f32_32x32x16_bf16(kf[7],qa_,c1,0,0,0),3,3); \
    if(GK){DMA_K((t)+3,sl_cur);} if(GV){DMA_V((t)+1,sl_next);} \
    BIASADD(c0,c1,t); \
    { float a=MX3(c0[0],c0[1],c1[0]),b=MX3(c0[2],c0[3],c1[1]); a=MX3(a,c1[2],c1[3]); \
      _Pragma("unroll") for(int r=4;r<16;r+=4){a=MX3(a,c0[r],c0[r+1]);b=MX3(b,c0[r+2],c0[r+3]);a=MX3(a,c1[r],c1[r+1]);b=MX3(b,c1[r+2],c1[r+3]);} \
      float rm=__builtin_fmaxf(a,b); { auto rr=__builtin_amdgcn_permlane32_swap(__float_as_uint(rm),__float_as_uint(rm),false,false); rm=__builtin_fmaxf(__uint_as_float(rr[0]),__uint_as_float(rr[1])); } \
      resc=false; \
      if(__builtin_expect(__any(rm>(float)THRL),0)){ const float dl=__builtin_fmaxf(rm,0.f); mhat+=dl; \
        _Pragma("unroll") for(int r=0;r<16;++r){c0[r]-=dl;c1[r]-=dl;} \
        nm=pc-mhat; \
        const float f=__builtin_amdgcn_exp2f(-dl); l_reg*=f; if(hi==0)wsf[r32]=f; resc=true; } } \
    SBAR(); \
    o[0]=__builtin_amdgcn_mfma_f32_32x32x16_bf16(PAFX(PO0),VFR(0),o[0],0,0,0); EXP2(c0,0);                       VRDW(0,4);  SBAR(); \
    o[1]=__builtin_amdgcn_mfma_f32_32x32x16_bf16(PAFX(PO0),VFR(1),o[1],0,0,0); EXP2(c0,2);  SUMPK(c0,0,PN0,0);  VRDW(1,5);  SBAR(); \
    o[2]=__builtin_amdgcn_mfma_f32_32x32x16_bf16(PAFX(PO0),VFR(2),o[2],0,0,0); EXP2(c0,4);  SUMPK(c0,2,PN0,1);  VRDW(2,6);  SBAR(); \
    o[3]=__builtin_amdgcn_mfma_f32_32x32x16_bf16(PAFX(PO0),VFR(3),o[3],0,0,0); EXP2(c0,6);  SUMPK(c0,4,PN0,2);  VRDW(3,7);  SBAR(); \
    o[0]=__builtin_amdgcn_mfma_f32_32x32x16_bf16(PAFX(PO1),VFR(0),o[0],0,0,0); EXP2(c0,8);  SUMPK(c0,6,PN0,3);  VRDW(0,8);  SBAR(); \
    o[1]=__builtin_amdgcn_mfma_f32_32x32x16_bf16(PAFX(PO1),VFR(1),o[1],0,0,0); EXP2(c0,10); SUMPK(c0,8,PN1,0);  VRDW(1,9);  SBAR(); \
    o[2]=__builtin_amdgcn_mfma_f32_32x32x16_bf16(PAFX(PO1),VFR(2),o[2],0,0,0); EXP2(c0,12); SUMPK(c0,10,PN1,1); VRDW(2,10); SBAR(); \
    o[3]=__builtin_amdgcn_mfma_f32_32x32x16_bf16(PAFX(PO1),VFR(3),o[3],0,0,0); EXP2(c0,14); SUMPK(c0,12,PN1,2); VRDW(3,11); SBAR(); \
    o[0]=__builtin_amdgcn_mfma_f32_32x32x16_bf16(PAFX(PO2),VFR(0),o[0],0,0,0); EXP2(c1,0);  SUMPK(c0,14,PN1,3); VRDW(0,12); KRD(GL,0); SBAR(); \
    o[1]=__builtin_amdgcn_mfma_f32_32x32x16_bf16(PAFX(PO2),VFR(1),o[1],0,0,0); EXP2(c1,2);  SUMPK(c1,0,PN2,0);  VRDW(1,13); KRD(GL,1); SBAR(); \
    o[2]=__builtin_amdgcn_mfma_f32_32x32x16_bf16(PAFX(PO2),VFR(2),o[2],0,0,0); EXP2(c1,4);  SUMPK(c1,2,PN2,1);  VRDW(2,14); KRD(GL,2); SBAR(); \
    o[3]=__builtin_amdgcn_mfma_f32_32x32x16_bf16(PAFX(PO2),VFR(3),o[3],0,0,0); EXP2(c1,6);  SUMPK(c1,4,PN2,2);  VRDW(3,15); KRD(GL,3); SBAR(); \
    o[0]=__builtin_amdgcn_mfma_f32_32x32x16_bf16(PAFX(PO3),VFR(0),o[0],0,0,0); EXP2(c1,8);  SUMPK(c1,6,PN2,3);              SBAR(); \
    o[1]=__builtin_amdgcn_mfma_f32_32x32x16_bf16(PAFX(PO3),VFR(1),o[1],0,0,0); EXP2(c1,10); SUMPK(c1,8,PN3,0);              SBAR(); \
    o[2]=__builtin_amdgcn_mfma_f32_32x32x16_bf16(PAFX(PO3),VFR(2),o[2],0,0,0); EXP2(c1,12); SUMPK(c1,10,PN3,1);             SBAR(); \
    o[3]=__builtin_amdgcn_mfma_f32_32x32x16_bf16(PAFX(PO3),VFR(3),o[3],0,0,0); EXP2(c1,14); SUMPK(c1,12,PN3,2);             SBAR(); \
    SUMPK(c1,14,PN3,3); l_reg+=sacc; \
    }while(0)
  #define STEP_AB(t,GK,GV,GL) STEP8(t,GK,GV,GL,pa0,pa1,pa2,pa3,pb0,pb1,pb2,pb3)
  #define STEP_BA(t,GK,GV,GL) STEP8(t,GK,GV,GL,pb0,pb1,pb2,pb3,pa0,pa1,pa2,pa3)
  int t=1;
  for(;t+5<NT;t+=2){
    STEP_AB(t,true,true,true);     WAIT_BAR(3); RESC(); ROT();
    STEP_BA(t+1,true,true,true);   WAIT_BAR(3); RESC(); ROT();
  }
  #define ENDW(tt) do{ if((tt)+3<NT){WAIT_BAR(3);} else if((tt)+1<NT){WAIT_BAR(2);} else {WAIT_BAR(0);} }while(0)
  for(;t+1<NT;t+=2){
    STEP_AB(t,(t+3<NT),(t+1<NT),(t+1<NT));       ENDW(t);   RESC(); ROT();
    STEP_BA(t+1,(t+4<NT),(t+2<NT),(t+2<NT));     ENDW(t+1); RESC(); ROT();
  }
  STEP_AB(NT-1,false,false,false); RESC();
  { const lds_cptr vp_=vp0+2*sl_cur;
    #pragma unroll
    for(int dq=0;dq<4;++dq){ s16x4 lo[4],hh[4];
      #pragma unroll
      for(int ks=0;ks<4;++ks){ lo[ks]=vtr(vp_+(dq*4096+ks*1024)); hh[ks]=vtr(vp_+(dq*4096+ks*1024+512)); }
      #define PK(k) (bf16x8){lo[k][0],lo[k][1],lo[k][2],lo[k][3],hh[k][0],hh[k][1],hh[k][2],hh[k][3]}
      o[dq]=__builtin_amdgcn_mfma_f32_32x32x16_bf16(PAFX(pb0),PK(0),o[dq],0,0,0);
      o[dq]=__builtin_amdgcn_mfma_f32_32x32x16_bf16(PAFX(pb1),PK(1),o[dq],0,0,0);
      o[dq]=__builtin_amdgcn_mfma_f32_32x32x16_bf16(PAFX(pb2),PK(2),o[dq],0,0,0);
      o[dq]=__builtin_amdgcn_mfma_f32_32x32x16_bf16(PAFX(pb3),PK(3),o[dq],0,0,0);
      #undef PK
    } }
  #undef PKW
  #undef PAFX
  #undef VFR
  #undef PIN
  #undef MX3
  #undef EX
  #undef VRDW
  #undef GAPA8
  #undef GAPA0
  #undef QLD
  #undef KRD
  #undef EXP2
  #undef SUMPK
  #undef STEP8
  #undef STEP_AB
  #undef STEP_BA
  #undef ENDW
  #undef BIASADD
  #undef SETPC
  {auto rr=__builtin_amdgcn_permlane32_swap(__float_as_uint(l_reg),__float_as_uint(l_reg),false,false);l_reg=__uint_as_float(rr[0])+__uint_as_float(rr[1]);}
  if(hi==0)wsf[32+r32]=l_reg;asm volatile("s_waitcnt lgkmcnt(0)":::"memory");
  float rli[16];
  #pragma unroll
  for(int r=0;r<16;++r)rli[r]=__builtin_amdgcn_rcpf(wsf[32+crow(r,hi)]);
  { float*Sp=Sw+r32;
    #pragma unroll
    for(int r=0;r<16;++r){const int orow=crow(r,hi);
      #pragma unroll
      for(int dq=0;dq<4;++dq){ float*p=Sp+orow*128+dq*32; const float v=o[dq][r]*rli[r]; if(lam==0.f)*p=v; else *p=*p-lam*v; } } }
  asm volatile("s_waitcnt lgkmcnt(0)\n\ts_barrier":::"memory");
  #undef DMA_K
  #undef DMA_V
  #undef RESC
  #undef ROT
}
#undef SBAR
#undef WAIT_BAR
}

#ifndef HELP_E0
#define HELP_E0 16
#endif
constexpr int CV_IN = 16 * 36, CV_OUT = 16 * 16, CV_EXP = 384, CV_ITEMS = CV_IN + CV_OUT + NEXP * CV_EXP;
constexpr int CV_SPLIT = CV_IN + CV_OUT + HELP_E0 * CV_EXP;
constexpr int CV_SCR = 64 * 65 * 4;
struct CvItem { const float* src; bf16* dst; int N, K, drow1; };
struct CvPtrs { const float *win, *wout, *wg, *wu, *wd; bf16 *WinT, *WoutT, *WguT, *WdT; };
__device__ __forceinline__ CvItem cv_decode(const CvPtrs& P, int it) {
    CvItem d; int r = it; d.drow1 = 32;
    if (r < CV_IN) { const int kb = r / 36, nb = r % 36, q = (2 * nb) & 7;
        d.N = INC; d.K = DM; d.src = P.win + (size_t)(64 * kb) * INC + 64 * nb; d.dst = P.WinT + (size_t)(((2 * nb) & ~7) * 32 + (q >> 1) * 32) * DM + 64 * kb; d.drow1 = 128; return d; }
    r -= CV_IN;
    if (r < CV_OUT) { const int kb = r / 16, nb = r % 16; d.N = DM; d.K = DM; d.src = P.wout + (size_t)(64 * kb) * DM + 64 * nb; d.dst = P.WoutT + (size_t)(64 * nb) * DM + 64 * kb; return d; }
    r -= CV_OUT;
    const int e = r / CV_EXP; r -= e * CV_EXP;
    if (r < 256) { const bool up = r >= 128; r &= 127; const int kb = r / 8, nb = r % 8, j0 = 64 * nb;
        d.N = DEXP; d.K = DM; d.src = (up ? P.wu : P.wg) + (size_t)e * DM * DEXP + (size_t)(64 * kb) * DEXP + j0;
        d.dst = P.WguT + (size_t)e * 1024 * 1024 + (size_t)((j0 >> 7) * 256 + (up ? 128 : 0) + (j0 & 127)) * DM + 64 * kb; return d; }
    r -= 256;
    { const int kb = r / 16, nb = r % 16; d.N = DM; d.K = DEXP; d.src = P.wd + (size_t)e * DEXP * DM + (size_t)(64 * kb) * DM + 64 * nb; d.dst = P.WdT + (size_t)e * 1024 * 512 + (size_t)(64 * nb) * DEXP + 64 * kb; return d; }
}
__device__ __forceinline__ void cv_load(const CvItem& d, f32x4 (&v)[16], int lane) {
    const float* p = d.src + (size_t)(lane >> 4) * d.N + 4 * (lane & 15);
#pragma unroll
    for (int i = 0; i < 16; ++i) v[i] = *(const f32x4*)(p + (size_t)(4 * i) * d.N);
}
__device__ __forceinline__ void cv_range(const CvPtrs& P, int it0, int it1, int w, int nw, LAS float* scr, int lane) {
    int it = it0 + w;
    if (it >= it1) return;
    CvItem d = cv_decode(P, it); f32x4 cur[16]; cv_load(d, cur, lane);
    for (;;) {
        const int itn = it + nw; const bool has = itn < it1;
        { LAS float* wp = scr + (lane >> 4) * 65 + 4 * (lane & 15);
#pragma unroll
          for (int i = 0; i < 16; ++i) { wp[(4 * i) * 65 + 0] = cur[i][0]; wp[(4 * i) * 65 + 1] = cur[i][1]; wp[(4 * i) * 65 + 2] = cur[i][2]; wp[(4 * i) * 65 + 3] = cur[i][3]; } }
        CvItem dn = d;
        if (has) { dn = cv_decode(P, itn); cv_load(dn, cur, lane); }
        asm volatile("s_waitcnt lgkmcnt(0)" ::: "memory");
        const int c = lane >> 3;
#pragma unroll
        for (int j = 0; j < 8; ++j) { const int n = (lane & 7) + 8 * j; const LAS float* sp = scr + (8 * c) * 65 + n;
            u32x4 o; o.x = pk2(sp[0 * 65], sp[1 * 65]); o.y = pk2(sp[2 * 65], sp[3 * 65]); o.z = pk2(sp[4 * 65], sp[5 * 65]); o.w = pk2(sp[6 * 65], sp[7 * 65]);
            const int drow = (n < 32) ? n : d.drow1 + (n - 32);
            *(u32x4*)(d.dst + (size_t)drow * d.K + 8 * c) = o; }
        asm volatile("s_waitcnt lgkmcnt(0)" ::: "memory");
        if (!has) break;
        d = dn; it = itn;
    }
}

__global__ void __launch_bounds__(NTHR, 2) fwd(Args args) {
    extern __shared__ __attribute__((aligned(16))) unsigned char lds_raw[];
    LAS unsigned char* lds = (LAS unsigned char*)lds_raw;
    volatile LAS unsigned* MISC = (volatile LAS unsigned*)(lds + MISC_OFF);
    const int tid = threadIdx.x, lane = tid & 63, wave = __builtin_amdgcn_readfirstlane(tid >> 6);
    const int G = gridDim.x, bid = blockIdx.x;
    unsigned char* ws = args.ws;
    unsigned* ctl = (unsigned*)(ws + WS_CTL);
    for (int u = tid; u < 32; u += NTHR) MISC[u] = 0u;
    __syncthreads();
    XcdBarrier bar; bar.bar = ctl + CW_BAR; bar.x = 0; bar.st = nullptr;
    if (MK_N_LAUNCHES == 1) bar = xcd_barrier_post(ctl + CW_BAR, MISC + 8);
    const int lo = args.ph_lo, hi = args.ph_hi; const bool dry = (args.pad & 1) != 0;
#define IN(k) (lo <= (k) && (k) < hi)
#define SEAM(k) do { if (IN(k) && IN((k) + 1)) xcd_barrier(bar); } while (0)

    const float* x = args.in[I_X];
    float* out = args.out;
    float* mod = (float*)(ws + WS_MOD);
    int* tokE = (int*)(ws + WS_TOKE); float* tokW = (float*)(ws + WS_TOKW); int* tokP = (int*)(ws + WS_TOKP);
    int* list = (int*)(ws + WS_LIST);
    bf16* WinT = (bf16*)(ws + WS_WIN); bf16* WoutT = (bf16*)(ws + WS_WOUT); bf16* WguT = (bf16*)(ws + WS_WGU); bf16* WdT = (bf16*)(ws + WS_WD);
    bf16* H = (bf16*)(ws + WS_H); bf16* PROJ = (bf16*)(ws + WS_PROJ); bf16* MIX = (bf16*)(ws + WS_MIX);
    bf16* HID = (bf16*)(ws + WS_HID); bf16* YS = (bf16*)(ws + WS_YS);
    const int gw = bid * NWAVES + wave, NGW = G * NWAVES;
    const int vcu = (G % 8 == 0) ? (bid % 8) * (G / 8) + bid / 8 : bid;

    if (IN(0)) {
        const float* c = args.in[I_C]; const float* w_ada = args.in[I_WADA]; const float* b_ada = args.in[I_BADA];
        if (bid < 192) {
            LAS float* sl = (LAS float*)lds;
            LAS f32x4* part = (LAS f32x4*)(lds + 32768);
            for (int i = tid; i < NB * DM; i += NTHR) { const float v = c[i]; sl[i] = v / (1.f + __expf(-v)); }
            __syncthreads();
            for (int item = bid; item < 192; item += G) {
                const int rg = tid >> 3, ch = tid & 7;
                const float* wp = w_ada + (size_t)rg * 6144 + item * 32 + ch * 4;
                f32x4 wv[16];
#pragma unroll
                for (int i = 0; i < 16; ++i) wv[i] = *(const f32x4*)(wp + (size_t)i * 64 * 6144);
                f32x4 acc[NB];
#pragma unroll
                for (int b = 0; b < NB; ++b) acc[b] = (f32x4){0.f, 0.f, 0.f, 0.f};
#pragma unroll
                for (int i = 0; i < 16; ++i)
#pragma unroll
                    for (int b = 0; b < NB; ++b) acc[b] += wv[i] * sl[b * DM + rg + 64 * i];
#pragma unroll
                for (int b = 0; b < NB; ++b) part[(rg * NB + b) * 8 + ch] = acc[b];
                __syncthreads();
                if (tid < 64) { const int b = tid >> 3, ch2 = tid & 7; f32x4 sum = (f32x4){0.f, 0.f, 0.f, 0.f};
                    for (int r = 0; r < 64; ++r) sum += part[(r * NB + b) * 8 + ch2];
                    const f32x4 bb = *(const f32x4*)(b_ada + item * 32 + ch2 * 4);
                    *(f32x4*)(mod + b * 6144 + item * 32 + ch2 * 4) = sum + bb; }
                __syncthreads();
            }
        }
        __syncthreads();
        if (bid == G - 1) { float* rope = (float*)(ws + WS_ROPE);
            for (int i = tid; i < 1024; i += NTHR) { const float ang = (float)(i >> 4) * powf(10000.f, -(float)(2 * (i & 15)) / 32.f); rope[i] = cosf(ang); rope[1024 + i] = sinf(ang); } }
        LAS float* scr = (LAS float*)(lds + wave * CV_SCR);
        const CvPtrs CP{args.in[I_WIN], args.in[I_WOUT], args.in[I_WGATE], args.in[I_WUP], args.in[I_WDOWN], WinT, WoutT, WguT, WdT};
        cv_range(CP, 0, CV_SPLIT, gw, NGW, scr, lane);
    }
    SEAM(0);

    if (IN(1)) {
        int lane_o = (int)__builtin_amdgcn_mbcnt_hi(~0u, __builtin_amdgcn_mbcnt_lo(~0u, 0u)); asm volatile("" : "+v"(lane_o)); const int lane = lane_o;
        for (int ck = bid; ck < T / 64; ck += G) {
            const int m0 = ck * 64 + wave * 8, b = m0 / SEQ;
            f32x4 sh[4], sc[4];
#pragma unroll
            for (int j = 0; j < 4; ++j) { sh[j] = ((const f32x4*)(mod + b * 6144))[64 * j + lane]; sc[j] = ((const f32x4*)(mod + b * 6144 + 1024))[64 * j + lane] + 1.f; }
            f32x4 nx[4];
#pragma unroll
            for (int j = 0; j < 4; ++j) nx[j] = ((const f32x4*)(x + (size_t)m0 * DM))[64 * j + lane];
#pragma unroll 1
            for (int r = 0; r < 8; ++r) {
                const int m = m0 + r;
                f32x4 v[4]; float s = 0.f;
#pragma unroll
                for (int j = 0; j < 4; ++j) { v[j] = nx[j]; s += (v[j].x + v[j].y) + (v[j].z + v[j].w); }
                if (r < 7) {
#pragma unroll
                    for (int j = 0; j < 4; ++j) nx[j] = ((const f32x4*)(x + (size_t)(m + 1) * DM))[64 * j + lane]; }
                const float mean = wave_sum(s) * (1.f / DM); float s2 = 0.f;
#pragma unroll
                for (int j = 0; j < 4; ++j) { v[j] = v[j] - mean; s2 += (v[j].x * v[j].x + v[j].y * v[j].y) + (v[j].z * v[j].z + v[j].w * v[j].w); }
                const float rstd = 1.f / sqrtf(wave_sum(s2) * (1.f / DM) + LN_EPS);
                unsigned long long* o8 = (unsigned long long*)(H + (size_t)m * DM) + lane;
#pragma unroll
                for (int j = 0; j < 4; ++j) { const f32x4 h = v[j] * rstd * sc[j] + sh[j];
                    o8[64 * j] = (unsigned long long)pk2(h.x, h.y) | ((unsigned long long)pk2(h.z, h.w) << 32); }
            }
        }
    }
    SEAM(1);

    if (IN(2)) {
        const int NG = (G >= 256) ? 192 : G;
        if (bid < NG) {
            pg8::Gemm g{H, WinT, DM}; pg8::StaticOrder S; S.init(T, INC, NG, bid);
            pg8::EpiProj E{PROJ, args.in[I_QNG], args.in[I_KNG], (const float*)(ws + WS_ROPE)};
            pg8::gemm_phase<pg8::EpiProj, pg8::StaticOrder, true, false>(lds, g, S, E, nullptr);
        }
        if (G < 256 || bid >= NG) {
            const CvPtrs CP{args.in[I_WIN], args.in[I_WOUT], args.in[I_WGATE], args.in[I_WUP], args.in[I_WDOWN], WinT, WoutT, WguT, WdT};
            const int nh = (G >= 256) ? (G - NG) : G, hb = (G >= 256) ? (bid - NG) : bid;
            cv_range(CP, CV_SPLIT, CV_ITEMS, hb * NWAVES + wave, nh * NWAVES, (LAS float*)(lds + wave * CV_SCR), lane);
        }
    }
    SEAM(2);


    if (IN(4)) {
        char* shm = (char*)lds_raw;
        const float* relb = args.in[I_RELB];
        float lam;
        { float d1 = 0.f, d2 = 0.f;
          for (int i = 0; i < 64; ++i) { d1 += args.in[I_LQ1][i] * args.in[I_LK1][i]; d2 += args.in[I_LQ2][i] * args.in[I_LK2][i]; }
          lam = expf(d1) - expf(d2) + LAMBDA_INIT; }
        float* Sw = out + ((size_t)bid * NWAVES + wave) * 4096;
        const attn::bf16* PJ = (const attn::bf16*)PROJ;
        for (int id = vcu; id < 256; id += G) {
            const int b = id >> 5, h = (id >> 3) & 3, qb = id & 7;
            __syncthreads();
            { int t2 = (int)threadIdx.x; asm volatile("" : "+v"(t2));
              LAS float* tb = (LAS float*)(lds + attn::L8_TB); const int rel = t2 - 256; const int n = rel < 0 ? -rel : rel;
              int bk; if (n < 8) bk = n; else { const int l2 = 31 - __clz(n * n); bk = 8 + l2 - 6; if (bk > 15) bk = 15; }
              if (rel > 0) bk += 16;
              tb[t2] = (relb[bk * 4 + h] - relb[15 * 4 + h]) * LOG2E; }
            __syncthreads();
            const float dlt = (relb[31 * 4 + h] - relb[15 * 4 + h]) * LOG2E;
            const size_t row0 = (size_t)b * SEQ + qb * 256;
#pragma unroll 1
            for (int cm = 0; cm < 2; ++cm)
                attn::attn_run128<8>(PJ + row0 * INC + C_DQ + h * 128 + cm * 64, PJ + (size_t)b * SEQ * INC + C_DK + h * 128 + cm * 64, PJ + (size_t)b * SEQ * INC + C_DV + h * 128,
                                     Sw, cm ? lam : 0.f, dlt, qb * 256, shm);
            asm volatile("s_waitcnt vmcnt(0)" ::: "memory");
            { int ln = (int)__builtin_amdgcn_mbcnt_hi(~0u, __builtin_amdgcn_mbcnt_lo(~0u, 0u)); asm volatile("" : "+v"(ln));
              const float* sg = args.in[I_SUBLN]; const float g0 = sg[2 * ln], g1 = sg[2 * ln + 1];
              const float* Sr = Sw + 2 * ln; bf16* Mr = MIX + (row0 + wave * 32) * DM + h * 128 + 2 * ln;
#pragma unroll 4
              for (int r = 0; r < 32; ++r) { const float d0 = Sr[r * 128], d1 = Sr[r * 128 + 1];
                const float ss = wave_sum(d0 * d0 + d1 * d1); const float rr = (1.f - LAMBDA_INIT) / sqrtf(ss * (1.f / 128.f) + RMS_EPS);
                *(unsigned*)(Mr + (size_t)r * DM) = pk2(d0 * rr * g0, d1 * rr * g1); } }
        }
        for (int id2 = vcu; id2 < 256; id2 += G)
#pragma unroll 1
            for (int i = 0; i < 2; ++i) { const int id = 2 * id2 + i; const int b = id >> 6, hd = (id >> 3) & 7, qb = id & 7;
                const size_t row0 = (size_t)b * SEQ + qb * 256;
                attn::attn_run<8, false>(PJ + row0 * INC + C_GQ + hd * 64, PJ + (size_t)b * SEQ * INC + C_GK + (hd >> 2) * 64, PJ + (size_t)b * SEQ * INC + C_GV + (hd >> 2) * 64,
                                         (attn::bf16*)MIX + row0 * DM + 512 + hd * 64, nullptr, 0, 0.f, 0.f, 0, shm); }
    }
    SEAM(4);

    if (IN(5)) {
        pg8::Gemm g{MIX, WoutT, DM}; pg8::StaticOrder S; S.init(T, DM, G, bid);
        pg8::EpiOut E{out, x, mod};
        pg8::gemm_phase<pg8::EpiOut, pg8::StaticOrder, false, false>(lds, g, S, E, nullptr);
    }
    SEAM(5);

    if (IN(6)) {
        int lane_o = (int)__builtin_amdgcn_mbcnt_hi(~0u, __builtin_amdgcn_mbcnt_lo(~0u, 0u)); asm volatile("" : "+v"(lane_o)); const int lane = lane_o;
        const float* g1v = args.in[I_LN1G]; const float* b1v = args.in[I_LN1B];
        const float* wrg = args.in[I_WRG]; const float* brg = args.in[I_BRG]; const float* wre = args.in[I_WRE]; const float* bre = args.in[I_BRE];
        LAS f32x4* wre4 = (LAS f32x4*)lds; LAS f32x4* wrg4 = (LAS f32x4*)(lds + AUX_OFF);
        LAS int* lcnt = (LAS int*)(lds + MISC_OFF + 256);
        LAS int* lsel = (LAS int*)(lds + MISC_OFF + 384);
        __syncthreads();
        for (int idx = tid; idx < 4 * 1024 * 2; idx += NTHR) { const int g = idx >> 11, col = (idx & 2047) >> 1, pl = idx & 1;
            wre4[(g * 2 + pl) * 1024 + (col & 3) * 256 + (col >> 8) * 64 + ((col & 255) >> 2)] = *(const f32x4*)(wre + (size_t)idx * 4); }
        for (int col = tid; col < 1024; col += NTHR) wrg4[(col & 3) * 256 + (col >> 8) * 64 + ((col & 255) >> 2)] = *(const f32x4*)(wrg + col * 4);
        f32x4 gg[4], bb[4];
#pragma unroll
        for (int j = 0; j < 4; ++j) { gg[j] = ((const f32x4*)g1v)[64 * j + lane]; bb[j] = ((const f32x4*)b1v)[64 * j + lane]; }
        for (int ck = bid; ck < T / 64; ck += G) {
            if (tid < 32) lcnt[tid] = 0;
            __syncthreads();
            const int m0 = ck * 64 + wave * 8, b = m0 / SEQ;
            f32x4 sh[4], sc[4];
#pragma unroll
            for (int j = 0; j < 4; ++j) { sh[j] = ((const f32x4*)(mod + b * 6144 + 3072))[64 * j + lane]; sc[j] = ((const f32x4*)(mod + b * 6144 + 4096))[64 * j + lane] + 1.f; }
            f32x4 nx[4];
#pragma unroll
            for (int j = 0; j < 4; ++j) nx[j] = ((const f32x4*)(out + (size_t)m0 * DM))[64 * j + lane];
#pragma unroll 1
            for (int r = 0; r < 8; ++r) {
                const int m = m0 + r;
                f32x4* yr = (f32x4*)((dry ? (float*)(ws + WS_PROJ) : out) + (size_t)m * DM) + lane;
                f32x4 v[4]; float s = 0.f;
#pragma unroll
                for (int j = 0; j < 4; ++j) { v[j] = nx[j]; s += (v[j].x + v[j].y) + (v[j].z + v[j].w); }
                if (r < 7) {
#pragma unroll
                    for (int j = 0; j < 4; ++j) nx[j] = ((const f32x4*)(out + (size_t)(m + 1) * DM))[64 * j + lane]; }
                float mean = wave_sum(s) * (1.f / DM); float s2 = 0.f;
#pragma unroll
                for (int j = 0; j < 4; ++j) { v[j] = v[j] - mean; s2 += (v[j].x * v[j].x + v[j].y * v[j].y) + (v[j].z * v[j].z + v[j].w * v[j].w); }
                float rstd = 1.f / sqrtf(wave_sum(s2) * (1.f / DM) + LN_EPS);
                s = 0.f;
#pragma unroll
                for (int j = 0; j < 4; ++j) { v[j] = v[j] * rstd * gg[j] + bb[j]; yr[64 * j] = v[j]; s += (v[j].x + v[j].y) + (v[j].z + v[j].w); }
                mean = wave_sum(s) * (1.f / DM); s2 = 0.f;
#pragma unroll
                for (int j = 0; j < 4; ++j) { v[j] = v[j] - mean; s2 += (v[j].x * v[j].x + v[j].y * v[j].y) + (v[j].z * v[j].z + v[j].w * v[j].w); }
                rstd = 1.f / sqrtf(wave_sum(s2) * (1.f / DM) + LN_EPS);
                unsigned long long* o8 = (unsigned long long*)(H + (size_t)m * DM) + lane;
#pragma unroll
                for (int j = 0; j < 4; ++j) { v[j] = v[j] * rstd * sc[j] + sh[j];
                    o8[64 * j] = (unsigned long long)pk2(v[j].x, v[j].y) | ((unsigned long long)pk2(v[j].z, v[j].w) << 32); }
                float lg[4] = {0.f, 0.f, 0.f, 0.f};
#pragma unroll
                for (int j = 0; j < 4; ++j)
#pragma unroll
                    for (int cc = 0; cc < 4; ++cc) { const float hv = v[j][cc]; const f32x4 wg = wrg4[cc * 256 + j * 64 + lane];
#pragma unroll
                        for (int o = 0; o < 4; ++o) lg[o] += hv * wg[o]; }
                float gl[4]; int gs = 0;
#pragma unroll
                for (int o = 0; o < 4; ++o) gl[o] = wave_sum(lg[o]) + brg[o];
                float gmax = gl[0];
#pragma unroll
                for (int o = 1; o < 4; ++o) if (gl[o] > gmax) { gmax = gl[o]; gs = o; }
                gs = __builtin_amdgcn_readfirstlane(gs);
                float den = 0.f;
#pragma unroll
                for (int o = 0; o < 4; ++o) den += expf(gl[o] - gmax);
                const float pg = 1.f / den;
                float el[8] = {0.f, 0.f, 0.f, 0.f, 0.f, 0.f, 0.f, 0.f};
                { const LAS f32x4* wb = wre4 + gs * 2048 + lane;
#pragma unroll
                  for (int j = 0; j < 4; ++j)
#pragma unroll
                    for (int cc = 0; cc < 4; ++cc) { const float hv = v[j][cc]; const f32x4 w0 = wb[cc * 256 + j * 64], w1 = wb[1024 + cc * 256 + j * 64];
#pragma unroll
                        for (int o = 0; o < 4; ++o) { el[o] += hv * w0[o]; el[4 + o] += hv * w1[o]; } } }
#pragma unroll
                for (int o = 0; o < 8; ++o) el[o] = wave_sum(el[o]) + bre[gs * 8 + o];
                int i1 = 0; float v1 = el[0];
#pragma unroll
                for (int o = 1; o < 8; ++o) if (el[o] > v1) { v1 = el[o]; i1 = o; }
                int i2 = -1; float v2 = -3.0e38f;
#pragma unroll
                for (int o = 0; o < 8; ++o) if (o != i1 && (i2 < 0 || el[o] > v2)) { v2 = el[o]; i2 = o; }
                if (lane == 0) {
                    const float ex = expf(v2 - v1);
                    const int e1 = gs * 8 + i1, e2 = gs * 8 + i2;
                    const int k1 = __hip_atomic_fetch_add(lcnt + e1, 1, __ATOMIC_RELAXED, __HIP_MEMORY_SCOPE_WORKGROUP);
                    const int k2 = __hip_atomic_fetch_add(lcnt + e2, 1, __ATOMIC_RELAXED, __HIP_MEMORY_SCOPE_WORKGROUP);
                    lsel[(wave * 8 + r) * 2] = e1 | (k1 << 8); lsel[(wave * 8 + r) * 2 + 1] = e2 | (k2 << 8);
                    tokE[2 * m] = e1; tokE[2 * m + 1] = e2; tokW[2 * m] = pg / (1.f + ex); tokW[2 * m + 1] = pg * ex / (1.f + ex);
                }
            }
            __syncthreads();
            if (tid < 32) { const int c = lcnt[tid]; lcnt[tid] = (c && !dry) ? (int)atomicAdd(ctl + CW_CNT + 64 * tid, (unsigned)c) : 0; }
            __syncthreads();
            if (tid < 128) { const int sel = lsel[tid]; const int e = sel & 255, pos = lcnt[e] + (sel >> 8); const int m = ck * 64 + (tid >> 1);
                if (!dry) { list[(size_t)e * T + pos] = m; tokP[2 * m + (tid & 1)] = pos; } }
            __syncthreads();
        }
    }
    SEAM(6);

    LAS int* toff = (LAS int*)(lds + AUX_OFF);
    if (hi > 7) {
        __syncthreads();
        if (tid == 0) { int acc = 0; for (int e = 0; e < NEXP; ++e) { const int cnt = (int)__hip_atomic_load(ctl + CW_CNT + 64 * e, __ATOMIC_RELAXED, __HIP_MEMORY_SCOPE_AGENT);
            toff[e] = acc; toff[64 + e] = cnt; acc += (cnt + 255) >> 8; } toff[32] = acc; }
        __syncthreads();
    }

    if (IN(7)) {
        LAS int* tokTab = (LAS int*)(lds + AUX_OFF + 4096);
        pg8::ExpertOrder S{toff, G, vcu};
        { pg8::Unit u;
          for (int i = 0; i < 4 && S.next(i, u); ++i) { const int e = u.pn >> 2; const int cnt = toff[64 + e]; const int r0 = (u.pm - toff[e]) * 256;
              for (int r = tid; r < 256; r += NTHR) tokTab[i * 256 + r] = (r0 + r < cnt) ? list[(size_t)e * T + r0 + r] : 0; } }
        __syncthreads();
        pg8::Gemm g{H, WguT, DM};
        pg8::EpiGateUp E{HID};
        pg8::gemm_phase<pg8::EpiGateUp, pg8::ExpertOrder, true, true>(lds, g, S, E, tokTab);
    }
    SEAM(7);

    if (IN(8)) {
        pg8::ExpertOrder S{toff, G, vcu};
        pg8::Gemm g{HID, WdT, DEXP};
        pg8::EpiDown E{YS};
        pg8::gemm_phase<pg8::EpiDown, pg8::ExpertOrder, true, false>(lds, g, S, E, nullptr);
    }
    SEAM(8);

    if (IN(9)) {
        int lane_o = (int)__builtin_amdgcn_mbcnt_hi(~0u, __builtin_amdgcn_mbcnt_lo(~0u, 0u)); asm volatile("" : "+v"(lane_o)); const int lane = lane_o;
        const float* g2v = args.in[I_LN2G]; const float* b2v = args.in[I_LN2B];
        f32x4 gg[4], bb[4];
#pragma unroll
        for (int j = 0; j < 4; ++j) { gg[j] = ((const f32x4*)g2v)[64 * j + lane]; bb[j] = ((const f32x4*)b2v)[64 * j + lane]; }
        for (int ck = bid; ck < T / 64; ck += G) {
            const int m0 = ck * 64 + wave * 8, b = m0 / SEQ;
            f32x4 g2[4];
#pragma unroll
            for (int j = 0; j < 4; ++j) g2[j] = ((const f32x4*)(mod + b * 6144 + 5120))[64 * j + lane] + 1.f;
            int myslot = 0; float myw = 0.f;
            if (lane < 16) { const int idx = 2 * m0 + lane; myslot = toff[tokE[idx]] * 256 + tokP[idx]; myw = tokW[idx]; }
            f32x4 nx[4]; u32x2 na[4], nb[4];
            { const int sa = __shfl(myslot, 0), sb = __shfl(myslot, 1);
#pragma unroll
              for (int j = 0; j < 4; ++j) { nx[j] = ((const f32x4*)(out + (size_t)m0 * DM))[64 * j + lane]; na[j] = ((const u32x2*)(YS + (size_t)sa * DM))[64 * j + lane]; nb[j] = ((const u32x2*)(YS + (size_t)sb * DM))[64 * j + lane]; } }
#pragma unroll 1
            for (int r = 0; r < 8; ++r) {
                const int m = m0 + r;
                const float wa = __shfl(myw, 2 * r), wb = __shfl(myw, 2 * r + 1);
                f32x4 v[4]; float s = 0.f;
#pragma unroll
                for (int j = 0; j < 4; ++j) { const u32x2 a = na[j], bq = nb[j];
                    f32x4 fa, fb;
                    fa.x = bf2f((unsigned short)(a.x & 0xffffu)); fa.y = bf2f((unsigned short)(a.x >> 16)); fa.z = bf2f((unsigned short)(a.y & 0xffffu)); fa.w = bf2f((unsigned short)(a.y >> 16));
                    fb.x = bf2f((unsigned short)(bq.x & 0xffffu)); fb.y = bf2f((unsigned short)(bq.x >> 16)); fb.z = bf2f((unsigned short)(bq.y & 0xffffu)); fb.w = bf2f((unsigned short)(bq.y >> 16));
                    v[j] = nx[j] * ALPHA + g2[j] * (fa * wa + fb * wb); s += (v[j].x + v[j].y) + (v[j].z + v[j].w); }
                if (r < 7) { const int sa = __shfl(myslot, 2 * r + 2), sb = __shfl(myslot, 2 * r + 3);
#pragma unroll
                    for (int j = 0; j < 4; ++j) { nx[j] = ((const f32x4*)(out + (size_t)(m + 1) * DM))[64 * j + lane]; na[j] = ((const u32x2*)(YS + (size_t)sa * DM))[64 * j + lane]; nb[j] = ((const u32x2*)(YS + (size_t)sb * DM))[64 * j + lane]; } }
                const float mean = wave_sum(s) * (1.f / DM); float s2 = 0.f;
#pragma unroll
                for (int j = 0; j < 4; ++j) { v[j] = v[j] - mean; s2 += (v[j].x * v[j].x + v[j].y * v[j].y) + (v[j].z * v[j].z + v[j].w * v[j].w); }
                const float rstd = 1.f / sqrtf(wave_sum(s2) * (1.f / DM) + LN_EPS);
                f32x4* xr = (f32x4*)((dry ? (float*)(ws + WS_WGU) : out) + (size_t)m * DM) + lane;
#pragma unroll
                for (int j = 0; j < 4; ++j) xr[64 * j] = v[j] * rstd * gg[j] + bb[j];
            }
        }
    }
#undef IN
#undef SEAM
}

extern "C" void kernel_launch(void* const* d_in, const int* in_sizes, int n_in, void* d_out, int out_size, void* d_ws, size_t ws_size, hipStream_t stream) {
    static int grid = 0;
    if (grid == 0) {
        if (n_in != 25 || out_size != T * DM || ws_size < WS_END) { fprintf(stderr, "kernel_launch: unexpected shapes (n_in %d out %d ws %zu)\n", n_in, out_size, ws_size); grid = -1; return; }
        int dev = 0, cus = 0, per_cu = 0;
        if (hipGetDevice(&dev) != hipSuccess || hipDeviceGetAttribute(&cus, hipDeviceAttributeMultiprocessorCount, dev) != hipSuccess) { grid = -1; return; }
        if (hipFuncSetAttribute((const void*)fwd, hipFuncAttributeMaxDynamicSharedMemorySize, LDS_BYTES) != hipSuccess) { fprintf(stderr, "kernel_launch: hipFuncSetAttribute failed\n"); grid = -1; return; }
        if (hipOccupancyMaxActiveBlocksPerMultiprocessor(&per_cu, (const void*)fwd, NTHR, LDS_BYTES) != hipSuccess || per_cu < 1) { fprintf(stderr, "kernel_launch: occupancy query says %d\n", per_cu); }
        (void)hipGetLastError();
        grid = cus;
    }
    if (grid < 0) return;
    (void)hipMemsetAsync((char*)d_ws + WS_CTL, 0, CTL_ZERO_BYTES, stream);
    Args a{};
    for (int i = 0; i < 25; ++i) a.in[i] = (const float*)d_in[i];
    a.out = (float*)d_out; a.ws = (unsigned char*)d_ws; a.pad = 0;
    if (MK_N_LAUNCHES == 1) {
        a.ph_lo = 0; a.ph_hi = NPH; a.li = 0;
        hipLaunchKernelGGL(fwd, dim3(grid), dim3(NTHR), LDS_BYTES, stream, a);
    } else {
        for (int p = 0; p < NPH; ++p) for (int rep = 0; rep < ((PROBE_REP == p) ? 2 : 1); ++rep) { a.ph_lo = p; a.ph_hi = p + 1; a.li = p; a.pad = (PROBE_REP == p && rep == 0 && (p == 6 || p == 9)) ? 1 : 0; hipLaunchKernelGGL(fwd, dim3(grid), dim3(NTHR), LDS_BYTES, stream, a); }
    }
}
```
